# Optimizing an MI355X kernel written in HIP

```python
import math
import jax, jax.numpy as jnp
from jax import lax
import numpy as np

D_MODEL = 1024
BATCH = 8
SEQ = 2048
DEPTH = 4

CHUNK = 64
QBLK = 128
DSA_QBLK = 64
EPS = 1e-6

LRU_WIDTH = D_MODEL // 2
LRU_BLOCKS = 8
LRU_BW = LRU_WIDTH // LRU_BLOCKS
CONV_W = 4
LRU_C = 8.0

MLA_HEADS = 8
MLA_NOPE = 64
MLA_ROPE = 32
MLA_V = 64
MLA_Q_RANK = D_MODEL // 4
MLA_KV_RANK = D_MODEL // 8
ROPE_THETA = 10000.0

EVEN_SPLITS = (LRU_WIDTH, LRU_WIDTH, MLA_Q_RANK, MLA_KV_RANK, MLA_ROPE)
EVEN_IN = sum(EVEN_SPLITS)
EVEN_MIX = LRU_WIDTH + MLA_HEADS * MLA_V

DSA_HEADS = 16
DSA_KV_HEADS = 4
DSA_HD = 64
IDX_HEADS = 8
IDX_HD = 64
TOPK_MAX = 256
ODD_SPLITS = (DSA_HEADS * DSA_HD, DSA_KV_HEADS * DSA_HD, DSA_KV_HEADS * DSA_HD,
              IDX_HEADS * IDX_HD, IDX_HD, IDX_HEADS)
ODD_IN = sum(ODD_SPLITS)
ODD_MIX = DSA_HEADS * DSA_HD

D_FF = 4 * D_MODEL

N_EVEN = (DEPTH + 1) // 2
N_ODD = DEPTH // 2

kernel_name = "hybrid_chunk_causal_rglru_mla_dsa"


def rms_norm(x, g):
    xf = x.astype(jnp.float32)
    y = xf * lax.rsqrt(jnp.mean(xf * xf, axis=-1, keepdims=True) + EPS)
    return (y * g.astype(jnp.float32)).astype(x.dtype)


def split_cols(u, sizes):
    offs = [int(o) for o in np.cumsum(sizes)[:-1]]
    return jnp.split(u, offs, axis=-1)


def rope(x, cos, sin):
    half = x.shape[-1] // 2
    x1, x2 = x[..., :half], x[..., half:]
    return jnp.concatenate([x1 * cos - x2 * sin, x1 * sin + x2 * cos], axis=-1)


def causal_conv(x, w, b):
    S = x.shape[1]
    xp = jnp.pad(x, ((0, 0), (CONV_W - 1, 0), (0, 0)))
    return sum(xp[:, j:j + S] * w[j] for j in range(CONV_W)) + b


def rg_lru(x, ga_w, ga_b, gx_w, gx_b, lam):
    B, S, W = x.shape
    xf = x.astype(jnp.float32)
    xb = xf.reshape(B, S, LRU_BLOCKS, LRU_BW)
    r = jax.nn.sigmoid(jnp.einsum('bsnk,nkj->bsnj', xb, ga_w.astype(jnp.float32)).reshape(B, S, W)
                       + ga_b.astype(jnp.float32))
    i = jax.nn.sigmoid(jnp.einsum('bsnk,nkj->bsnj', xb, gx_w.astype(jnp.float32)).reshape(B, S, W)
                       + gx_b.astype(jnp.float32))
    log_a = -LRU_C * r * jax.nn.softplus(-lam.astype(jnp.float32))
    a = jnp.exp(log_a)
    mult = jnp.sqrt(-jnp.expm1(2.0 * log_a))
    bterm = mult * (i * xf)

    def combine(left, right):
        a_l, b_l = left
        a_r, b_r = right
        return a_l * a_r, a_r * b_l + b_r

    _, h = lax.associative_scan(combine, (a, bterm), axis=1)
    return h.astype(x.dtype)


def mla_attention(q_nope, q_rope, k_nope, k_rope, v):
    S = q_nope.shape[1]
    scale = (MLA_NOPE + MLA_ROPE) ** -0.5
    outs = []
    for blk in range(S // QBLK):
        q0, q1 = blk * QBLK, (blk + 1) * QBLK
        s = (jnp.einsum('bqhd,bkhd->bhqk', q_nope[:, q0:q1], k_nope[:, :q1])
             + jnp.einsum('bqhr,bkr->bhqk', q_rope[:, q0:q1], k_rope[:, :q1]))
        s = s.astype(jnp.float32) * scale
        qi = jnp.arange(q0, q1) // CHUNK
        ki = jnp.arange(q1) // CHUNK
        mask = ki[None, :] <= qi[:, None]
        s = jnp.where(mask, s, -jnp.inf)
        p = jax.nn.softmax(s, axis=-1).astype(v.dtype)
        outs.append(jnp.einsum('bhqk,bkhd->bqhd', p, v[:, :q1]))
    return jnp.concatenate(outs, axis=1)


def dsa_attention(q, k, v, q_idx, k_idx, w_idx):
    B, S = q.shape[0], q.shape[1]
    topk = min(TOPK_MAX, S // 4)
    rep = DSA_HEADS // DSA_KV_HEADS
    scale = DSA_HD ** -0.5
    idx_scale = IDX_HD ** -0.5
    bidx = jnp.arange(B)[:, None, None]
    outs = []
    for blk in range(S // DSA_QBLK):
        q0, q1 = blk * DSA_QBLK, (blk + 1) * DSA_QBLK
        kl = min(S, max(q1, topk))
        qi = jnp.arange(q0, q1) // CHUNK
        ki = jnp.arange(kl) // CHUNK
        adm = ki[None, :] <= qi[:, None]
        logits = jnp.einsum('bqhd,bkd->bqhk', q_idx[:, q0:q1], k_idx[:, :kl]).astype(jnp.float32) * idx_scale
        score = jnp.einsum('bqh,bqhk->bqk', w_idx[:, q0:q1].astype(jnp.float32), jax.nn.relu(logits))
        score = jnp.where(adm[None], score, -jnp.inf)
        _, sel = lax.top_k(score, topk)
        valid = (sel // CHUNK) <= qi[None, :, None]
        ks = k[bidx, sel]
        vs = v[bidx, sel]
        qb = q[:, q0:q1].reshape(B, DSA_QBLK, DSA_KV_HEADS, rep, DSA_HD)
        s = jnp.einsum('bqgrd,bqkgd->bgrqk', qb, ks).astype(jnp.float32) * scale
        s = jnp.where(valid[:, None, None], s, -jnp.inf)
        p = jax.nn.softmax(s, axis=-1).astype(v.dtype)
        o = jnp.einsum('bgrqk,bqkgd->bqgrd', p, vs)
        outs.append(o.reshape(B, DSA_QBLK, DSA_HEADS * DSA_HD))
    return jnp.concatenate(outs, axis=1)


def even_mixer(x, cos, sin, norm_g, w_in, conv_w, conv_b, ga_w, ga_b, gx_w, gx_b, lam,
               q_norm, w_uq, kv_norm, w_ukv, w_out):
    B, S, _ = x.shape
    h = rms_norm(x, norm_g)
    u = h @ w_in
    xr, gr, cq, ckv, kr = split_cols(u, EVEN_SPLITS)
    hr = rg_lru(causal_conv(xr, conv_w, conv_b), ga_w, ga_b, gx_w, gx_b, lam)
    y_lru = hr * jax.nn.gelu(gr)
    q = (rms_norm(cq, q_norm) @ w_uq).reshape(B, S, MLA_HEADS, MLA_NOPE + MLA_ROPE)
    q_nope, q_rope = q[..., :MLA_NOPE], q[..., MLA_NOPE:]
    kv = (rms_norm(ckv, kv_norm) @ w_ukv).reshape(B, S, MLA_HEADS, MLA_NOPE + MLA_V)
    k_nope, v = kv[..., :MLA_NOPE], kv[..., MLA_NOPE:]
    q_rope = rope(q_rope, cos[:, :, None, :], sin[:, :, None, :])
    k_rope = rope(kr, cos, sin)
    y_mla = mla_attention(q_nope, q_rope, k_nope, k_rope, v).reshape(B, S, MLA_HEADS * MLA_V)
    return jnp.concatenate([y_lru, y_mla], axis=-1) @ w_out


def odd_mixer(x, norm_g, w_in, idx_k_norm, w_out):
    B, S, _ = x.shape
    h = rms_norm(x, norm_g)
    u = h @ w_in
    q, k, v, qi, ki, wi = split_cols(u, ODD_SPLITS)
    q = q.reshape(B, S, DSA_HEADS, DSA_HD)
    k = k.reshape(B, S, DSA_KV_HEADS, DSA_HD)
    v = v.reshape(B, S, DSA_KV_HEADS, DSA_HD)
    qi = qi.reshape(B, S, IDX_HEADS, IDX_HD)
    ki = rms_norm(ki, idx_k_norm)
    wi = wi * (IDX_HEADS ** -0.5)
    return dsa_attention(q, k, v, qi, ki, wi) @ w_out


def mlp(x, norm_g, w1, w2):
    h = rms_norm(x, norm_g)
    return jnp.square(jax.nn.relu(h @ w1)) @ w2


def setup_inputs(seed: int = 0) -> dict:
    key = jax.random.key(seed)
    ks = iter(jax.random.split(key, 32))
    f32 = jnp.float32

    def nrm(shape, fan_in):
        return jax.random.normal(next(ks), shape, f32) * (fan_in ** -0.5)

    def gain(shape):
        return 1.0 + 0.02 * jax.random.normal(next(ks), shape, f32)

    def bias(shape):
        return 0.02 * jax.random.normal(next(ks), shape, f32)

    x = jax.random.normal(next(ks), (BATCH, SEQ, D_MODEL), f32)
    positions = jnp.broadcast_to(jnp.arange(SEQ, dtype=jnp.int32), (BATCH, SEQ))
    a0 = jax.random.uniform(next(ks), (N_EVEN, LRU_WIDTH), f32, 0.9, 0.999)
    p = a0 ** (1.0 / LRU_C)
    lam = jnp.log(p) - jnp.log1p(-p)
    return {
        "x": x,
        "positions": positions,
        "e_norm": gain((N_EVEN, D_MODEL)),
        "e_w_in": nrm((N_EVEN, D_MODEL, EVEN_IN), D_MODEL),
        "e_conv_w": nrm((N_EVEN, CONV_W, LRU_WIDTH), CONV_W),
        "e_conv_b": bias((N_EVEN, LRU_WIDTH)),
        "e_ga_w": nrm((N_EVEN, LRU_BLOCKS, LRU_BW, LRU_BW), LRU_BW),
        "e_ga_b": bias((N_EVEN, LRU_WIDTH)),
        "e_gx_w": nrm((N_EVEN, LRU_BLOCKS, LRU_BW, LRU_BW), LRU_BW),
        "e_gx_b": bias((N_EVEN, LRU_WIDTH)),
        "e_lambda": lam,
        "e_q_norm": gain((N_EVEN, MLA_Q_RANK)),
        "e_w_uq": nrm((N_EVEN, MLA_Q_RANK, MLA_HEADS * (MLA_NOPE + MLA_ROPE)), MLA_Q_RANK),
        "e_kv_norm": gain((N_EVEN, MLA_KV_RANK)),
        "e_w_ukv": nrm((N_EVEN, MLA_KV_RANK, MLA_HEADS * (MLA_NOPE + MLA_V)), MLA_KV_RANK),
        "e_w_out": nrm((N_EVEN, EVEN_MIX, D_MODEL), EVEN_MIX),
        "o_norm": gain((N_ODD, D_MODEL)),
        "o_w_in": nrm((N_ODD, D_MODEL, ODD_IN), D_MODEL),
        "o_idx_k_norm": gain((N_ODD, IDX_HD)),
        "o_w_out": nrm((N_ODD, ODD_MIX, D_MODEL), ODD_MIX),
        "m_norm": gain((DEPTH, D_MODEL)),
        "m_w1": nrm((DEPTH, D_MODEL, D_FF), D_MODEL),
        "m_w2": nrm((DEPTH, D_FF, D_MODEL), D_FF),
        "final_norm": gain((D_MODEL,)),
    }


def reference(x, positions, e_norm, e_w_in, e_conv_w, e_conv_b, e_ga_w, e_ga_b, e_gx_w, e_gx_b,
              e_lambda, e_q_norm, e_w_uq, e_kv_norm, e_w_ukv, e_w_out, o_norm, o_w_in,
              o_idx_k_norm, o_w_out, m_norm, m_w1, m_w2, final_norm):
    freqs = ROPE_THETA ** (-jnp.arange(0, MLA_ROPE, 2, dtype=jnp.float32) / MLA_ROPE)
    ang = positions.astype(jnp.float32)[..., None] * freqs
    cos = jnp.cos(ang).astype(x.dtype)
    sin = jnp.sin(ang).astype(x.dtype)
    for l in range(DEPTH):
        j = l // 2
        if l % 2 == 0:
            x = x + even_mixer(x, cos, sin, e_norm[j], e_w_in[j], e_conv_w[j], e_conv_b[j],
                               e_ga_w[j], e_ga_b[j], e_gx_w[j], e_gx_b[j], e_lambda[j],
                               e_q_norm[j], e_w_uq[j], e_kv_norm[j], e_w_ukv[j], e_w_out[j])
        else:
            x = x + odd_mixer(x, o_norm[j], o_w_in[j], o_idx_k_norm[j], o_w_out[j])
        x = x + mlp(x, m_norm[l], m_w1[l], m_w2[l])
    return rms_norm(x, final_norm)
```

```cpp
#include <hip/hip_runtime.h>
#include <hip/hip_cooperative_groups.h>
#include <stdint.h>
#include <string.h>
#include <stdio.h>
namespace cg = cooperative_groups;

#ifndef MULTI_LAUNCH
#define MULTI_LAUNCH 0
#endif

typedef __attribute__((ext_vector_type(8))) short bf16x8;
typedef __attribute__((ext_vector_type(16))) float f32x16;
typedef __attribute__((ext_vector_type(4))) float f32x4;
typedef unsigned short bf16_t;

#define DI __device__ __forceinline__
#define MFMA32(a, b, c) __builtin_amdgcn_mfma_f32_32x32x16_bf16((a), (b), (c), 0, 0, 0)
#define MFMA16(a, b, c) __builtin_amdgcn_mfma_f32_16x16x32_bf16((a), (b), (c), 0, 0, 0)
#define CROW(i, h) (((i) & 3) + 8 * ((i) >> 2) + 4 * (h))

constexpr int S = 2048, T = 16384;
constexpr float EPSV = 1e-6f;
constexpr float LOG2E = 1.4426950408889634f;
constexpr int NPHASE = 26;
constexpr int SMEM_BYTES = 66688;

constexpr size_t MiB = 1ull << 20;
constexpr size_t OFF_X = 0, OFF_XB = 64 * MiB, OFF_WMLP = 96 * MiB, OFF_WMIX = 112 * MiB, OFF_MISC = 119 * MiB, OFF_R = 124 * MiB;

struct Params {
  const float* in[24];
  const int* pos;
  float* out;
  char* ws;
  int phase_lo, phase_hi;
  int pad0, pad1;
};

DI int TIDX() { int t = __builtin_amdgcn_workitem_id_x(); asm volatile("" : "+v"(t)); return t; }
typedef __attribute__((ext_vector_type(2))) __bf16 bf2v_t;
typedef __attribute__((ext_vector_type(2))) float f2v_t;
DI bf16_t f2bf(float x) { __bf16 r = (__bf16)x; return __builtin_bit_cast(bf16_t, r); }
DI float bf2f(bf16_t b) { return __uint_as_float(((unsigned)b) << 16); }
DI unsigned pack2(float a, float b) { f2v_t v = {a, b}; bf2v_t r = __builtin_convertvector(v, bf2v_t); return __builtin_bit_cast(unsigned, r); }
DI float lo2f(unsigned v) { return __uint_as_float(v << 16); }
DI float hi2f(unsigned v) { return __uint_as_float(v & 0xffff0000u); }
DI f32x16 zero16() { f32x16 z;
#pragma unroll
  for (int i = 0; i < 16; ++i) z[i] = 0.f; return z; }
DI float sigmoidf_(float x) { return 1.f / (1.f + __expf(-x)); }
DI float gelu_tanh(float x) { float y = 0.7978845608028654f * (x + 0.044715f * x * x * x); float t = 1.f - 2.f / (__expf(2.f * y) + 1.f); return 0.5f * x * (1.f + t); }
DI float sumsq8(const uint4& v) {
  float s = 0.f;
  s += lo2f(v.x) * lo2f(v.x); s += hi2f(v.x) * hi2f(v.x);
  s += lo2f(v.y) * lo2f(v.y); s += hi2f(v.y) * hi2f(v.y);
  s += lo2f(v.z) * lo2f(v.z); s += hi2f(v.z) * hi2f(v.z);
  s += lo2f(v.w) * lo2f(v.w); s += hi2f(v.w) * hi2f(v.w);
  return s;
}

typedef __attribute__((ext_vector_type(2))) __bf16 bf2_t;
DI float sumsq_frag(const bf16x8& f, float acc) {
  const uint4 u = __builtin_bit_cast(uint4, f);
  acc = __builtin_amdgcn_fdot2_f32_bf16(__builtin_bit_cast(bf2_t, u.x), __builtin_bit_cast(bf2_t, u.x), acc, false);
  acc = __builtin_amdgcn_fdot2_f32_bf16(__builtin_bit_cast(bf2_t, u.y), __builtin_bit_cast(bf2_t, u.y), acc, false);
  acc = __builtin_amdgcn_fdot2_f32_bf16(__builtin_bit_cast(bf2_t, u.z), __builtin_bit_cast(bf2_t, u.z), acc, false);
  acc = __builtin_amdgcn_fdot2_f32_bf16(__builtin_bit_cast(bf2_t, u.w), __builtin_bit_cast(bf2_t, u.w), acc, false);
  return acc;
}

template <bool NORM, class Epi>
DI void gemm_tile(char* smem, const bf16_t* a0, int lda0, const bf16_t* a1, int lda1, int ksplit,
                  const bf16_t* Wt, int K, int m0, int n0, float inv_nk, Epi epi) {
  __syncthreads();
  float* rs = (float*)(smem + 65536);
  const int tid = TIDX(), lane = tid & 63, w = tid >> 6, r = lane & 31, h = lane >> 5, wm = w >> 1, wn = w & 1;
  const int nkt = K >> 6;
  const int grow = w * 8 + (lane >> 3);
  const int gch = ((lane & 7) ^ ((4 * (w & 1) + (lane >> 4)) & 7)) * 8;
  const bf16_t* bsrc = Wt + (size_t)(n0 + grow) * K + gch;
  const size_t bstep = (size_t)32 * K;
  auto glds = [&](int kt, int buf) __attribute__((always_inline)) {
    const int k = kt * 64;
    const bf16_t* ab; int lda;
    if (k < ksplit) { ab = a0 + k; lda = lda0; } else { ab = a1 + (k - ksplit); lda = lda1; }
    const bf16_t* asrc = ab + (size_t)(m0 + grow) * lda + gch;
    const size_t astep = (size_t)32 * lda;
    char* lb = smem + buf * 32768 + w * 1024;
    __builtin_amdgcn_global_load_lds((const unsigned*)(asrc), (__attribute__((address_space(3))) unsigned*)(lb), 16, 0, 0);
    __builtin_amdgcn_global_load_lds((const unsigned*)(asrc + astep), (__attribute__((address_space(3))) unsigned*)(lb + 4096), 16, 0, 0);
    __builtin_amdgcn_global_load_lds((const unsigned*)(asrc + 2 * astep), (__attribute__((address_space(3))) unsigned*)(lb + 8192), 16, 0, 0);
    __builtin_amdgcn_global_load_lds((const unsigned*)(asrc + 3 * astep), (__attribute__((address_space(3))) unsigned*)(lb + 12288), 16, 0, 0);
    __builtin_amdgcn_global_load_lds((const unsigned*)(bsrc + k), (__attribute__((address_space(3))) unsigned*)(lb + 16384), 16, 0, 0);
    __builtin_amdgcn_global_load_lds((const unsigned*)(bsrc + k + bstep), (__attribute__((address_space(3))) unsigned*)(lb + 16384 + 4096), 16, 0, 0);
    __builtin_amdgcn_global_load_lds((const unsigned*)(bsrc + k + 2 * bstep), (__attribute__((address_space(3))) unsigned*)(lb + 16384 + 8192), 16, 0, 0);
    __builtin_amdgcn_global_load_lds((const unsigned*)(bsrc + k + 3 * bstep), (__attribute__((address_space(3))) unsigned*)(lb + 16384 + 12288), 16, 0, 0);
  };
  f32x16 acc00 = zero16(), acc01 = zero16(), acc10 = zero16(), acc11 = zero16();
  float ss0 = 0.f, ss1 = 0.f;
  const int sw = (r >> 1) & 7;
  const int aoff = (wm * 64 + r) * 128, boff = 16384 + (wn * 64 + r) * 128;
  glds(0, 0);
  for (int kt = 0; kt < nkt; ++kt) {
    asm volatile("s_waitcnt vmcnt(0)" ::: "memory");
    asm volatile("s_waitcnt lgkmcnt(0)" ::: "memory");
    __builtin_amdgcn_s_barrier();
    const char* base = smem + (kt & 1) * 32768;
    bf16x8 af0[4], af1[4], bf0[4], bf1[4];
#pragma unroll
    for (int ks = 0; ks < 4; ++ks) {
      const int p = ((2 * ks + h) ^ sw) * 16;
      af0[ks] = *(const bf16x8*)(base + aoff + p); af1[ks] = *(const bf16x8*)(base + aoff + 4096 + p);
      bf0[ks] = *(const bf16x8*)(base + boff + p); bf1[ks] = *(const bf16x8*)(base + boff + 4096 + p);
    }
    __builtin_amdgcn_sched_barrier(0);
    if (kt + 1 < nkt) glds(kt + 1, (kt + 1) & 1);
    __builtin_amdgcn_sched_barrier(0);
#pragma unroll
    for (int ks = 0; ks < 4; ++ks) {
      if (NORM) { ss0 = sumsq_frag(af0[ks], ss0); ss1 = sumsq_frag(af1[ks], ss1); }
      acc00 = MFMA32(af0[ks], bf0[ks], acc00); acc01 = MFMA32(af0[ks], bf1[ks], acc01);
      acc10 = MFMA32(af1[ks], bf0[ks], acc10); acc11 = MFMA32(af1[ks], bf1[ks], acc11);
    }
  }
  if (NORM) {
    ss0 += __shfl_xor(ss0, 32); ss1 += __shfl_xor(ss1, 32);
    if (wn == 0 && h == 0) { rs[wm * 64 + r] = rsqrtf(ss0 * inv_nk + EPSV); rs[wm * 64 + 32 + r] = rsqrtf(ss1 * inv_nk + EPSV); }
    __syncthreads();
  }
  epi(m0 + wm * 64, n0 + wn * 64, acc00, acc01, rs + wm * 64);
  epi(m0 + wm * 64 + 32, n0 + wn * 64, acc10, acc11, rs + wm * 64 + 32);
}

template <bool NORM, class Epi>
DI void gemm_tile_big(char* smem, const bf16_t* A, int lda, const bf16_t* Wt, int K, int m0, int n0, float inv_nk, Epi epi,
                       const bf16_t* A2 = nullptr, int ksplit = 1 << 30) {
  __syncthreads();
  float* rs = (float*)(smem + 65536);
  const int tid = TIDX(), lane = tid & 63, w = tid >> 6, r = lane & 31, h = lane >> 5, wm = w >> 1, wn = w & 1;
  const int nkt = K >> 5;
  const int wu = __builtin_amdgcn_readfirstlane(w);
  const int grow = wu * 16 + (lane >> 2);
  const int gch = ((lane & 3) ^ ((lane >> 4) & 3)) * 8;
  const unsigned aoffl = (unsigned)(grow * lda + gch) * 2u;
  const unsigned boffl = (unsigned)(grow * K + gch) * 2u;
  const char* abase = (const char*)(A + (size_t)m0 * lda);
  const char* abase2 = A2 ? (const char*)(A2 + (size_t)m0 * lda) - (size_t)ksplit * 2 : abase;
  const char* bbase = (const char*)(Wt + (size_t)n0 * K);
  const size_t astep = (size_t)64 * lda * 2, bstep = (size_t)64 * K * 2;
  auto glds = [&](int kt, int buf) __attribute__((always_inline)) {
    const size_t kb = (size_t)kt * 64;
    char* lb = smem + buf * 24576 + wu * 1024;
    const char* u0 = ((kt * 32 < ksplit) ? abase : abase2) + kb; const char* u1 = u0 + astep; const char* u2 = u1 + astep; const char* u3 = u2 + astep;
    const char* v0 = bbase + kb; const char* v1 = v0 + bstep;
    asm volatile("" : "+s"(u0), "+s"(u1), "+s"(u2), "+s"(u3), "+s"(v0), "+s"(v1));
    __builtin_amdgcn_global_load_lds((const unsigned*)(u0 + (size_t)aoffl), (__attribute__((address_space(3))) unsigned*)(lb), 16, 0, 0);
    __builtin_amdgcn_global_load_lds((const unsigned*)(u1 + (size_t)aoffl), (__attribute__((address_space(3))) unsigned*)(lb + 4096), 16, 0, 0);
    __builtin_amdgcn_global_load_lds((const unsigned*)(u2 + (size_t)aoffl), (__attribute__((address_space(3))) unsigned*)(lb + 8192), 16, 0, 0);
    __builtin_amdgcn_global_load_lds((const unsigned*)(u3 + (size_t)aoffl), (__attribute__((address_space(3))) unsigned*)(lb + 12288), 16, 0, 0);
    __builtin_amdgcn_global_load_lds((const unsigned*)(v0 + (size_t)boffl), (__attribute__((address_space(3))) unsigned*)(lb + 16384), 16, 0, 0);
    __builtin_amdgcn_global_load_lds((const unsigned*)(v1 + (size_t)boffl), (__attribute__((address_space(3))) unsigned*)(lb + 16384 + 4096), 16, 0, 0);
  };
  f32x16 acc[4][2];
#pragma unroll
  for (int mt = 0; mt < 4; ++mt) { acc[mt][0] = zero16(); acc[mt][1] = zero16(); }
  float ss[4] = {0.f, 0.f, 0.f, 0.f};
  const int sw = (r >> 2) & 3;
  const int aoff = (wm * 128 + r) * 64, boff = 16384 + (wn * 64 + r) * 64;
  const int p0 = ((0 + h) ^ sw) * 16, p1 = ((2 + h) ^ sw) * 16;
  __builtin_amdgcn_s_waitcnt(0x0F70);
  glds(0, 0);
  for (int kt = 0; kt < nkt; ++kt) {
    __builtin_amdgcn_s_waitcnt(0x0070);
    __builtin_amdgcn_s_barrier();
    const char* base = smem + (kt & 1) * 24576;
    bf16x8 af[4][2], bf[2][2];
#pragma unroll
    for (int mt = 0; mt < 4; ++mt) { af[mt][0] = *(const bf16x8*)(base + aoff + mt * 2048 + p0); af[mt][1] = *(const bf16x8*)(base + aoff + mt * 2048 + p1); }
#pragma unroll
    for (int nt = 0; nt < 2; ++nt) { bf[nt][0] = *(const bf16x8*)(base + boff + nt * 2048 + p0); bf[nt][1] = *(const bf16x8*)(base + boff + nt * 2048 + p1); }
    __builtin_amdgcn_sched_barrier(0);
    if (kt + 1 < nkt) glds(kt + 1, (kt + 1) & 1);
    __builtin_amdgcn_sched_barrier(0);
#pragma unroll
    for (int ks = 0; ks < 2; ++ks)
#pragma unroll
      for (int mt = 0; mt < 4; ++mt) {
        if (NORM) ss[mt] = sumsq_frag(af[mt][ks], ss[mt]);
        acc[mt][0] = MFMA32(af[mt][ks], bf[0][ks], acc[mt][0]);
        acc[mt][1] = MFMA32(af[mt][ks], bf[1][ks], acc[mt][1]);
      }
  }
  if (NORM) {
#pragma unroll
    for (int mt = 0; mt < 4; ++mt) {
      ss[mt] += __shfl_xor(ss[mt], 32);
      if (wn == 0 && h == 0) rs[wm * 128 + mt * 32 + r] = rsqrtf(ss[mt] * inv_nk + EPSV);
    }
    __syncthreads();
  }
#pragma unroll
  for (int mt = 0; mt < 4; ++mt) epi(m0 + wm * 128 + mt * 32, n0 + wn * 64, acc[mt][0], acc[mt][1], rs + wm * 128 + mt * 32);
}

DI void conv_tile(char* smem, const float* __restrict__ src, int K, int N, const float* __restrict__ gain, bf16_t* __restrict__ dst, int tile, int ntn) {
  __syncthreads();
  const int tid = TIDX();
  const int kt = tile / ntn, nt = tile - kt * ntn, k0 = kt * 64, n0 = nt * 64;
  float* t = (float*)smem;
  float cv[16];
#pragma unroll
  for (int it = 0; it < 16; ++it) {
    const int e = tid + 256 * it, kk = e >> 6, nn = e & 63, n = n0 + nn;
    cv[it] = (n < N) ? src[(size_t)(k0 + kk) * N + n] : 0.f;
  }
  float gv[16];
  if (gain) {
#pragma unroll
    for (int it = 0; it < 16; ++it) gv[it] = gain[k0 + ((tid + 256 * it) >> 6)];
  } else {
#pragma unroll
    for (int it = 0; it < 16; ++it) gv[it] = 1.f;
  }
#pragma unroll
  for (int it = 0; it < 16; ++it) {
    const int e = tid + 256 * it, kk = e >> 6, nn = e & 63;
    t[kk * 65 + nn] = cv[it] * gv[it];
  }
  __syncthreads();
#pragma unroll
  for (int it = 0; it < 2; ++it) {
    const int e = tid + 256 * it, nn = e >> 3, ko = (e & 7) * 8;
    uint4 o;
    o.x = pack2(t[(ko + 0) * 65 + nn], t[(ko + 1) * 65 + nn]);
    o.y = pack2(t[(ko + 2) * 65 + nn], t[(ko + 3) * 65 + nn]);
    o.z = pack2(t[(ko + 4) * 65 + nn], t[(ko + 5) * 65 + nn]);
    o.w = pack2(t[(ko + 6) * 65 + nn], t[(ko + 7) * 65 + nn]);
    *(uint4*)(dst + (size_t)(n0 + nn) * K + k0 + ko) = o;
  }
}

constexpr int CONV_MLP_ITEMS = 2048;
DI void conv_mlp_item(const Params& p, char* smem, int l, int item) {
  bf16_t* w1t = (bf16_t*)(p.ws + OFF_WMLP);
  bf16_t* w2t = (bf16_t*)(p.ws + OFF_WMLP + 8 * MiB);
  if (item < 1024) conv_tile(smem, p.in[21] + (size_t)l * 1024 * 4096, 1024, 4096, p.in[20] + l * 1024, w1t, item, 64);
  else conv_tile(smem, p.in[22] + (size_t)l * 4096 * 1024, 4096, 1024, nullptr, w2t, item - 1024, 16);
}
DI int conv_mix_count(int l) { return (l & 1) ? 800 : 736; }
DI void conv_mix_item(const Params& p, char* smem, int l, int item) {
  const int j = l >> 1;
  char* wm = p.ws + OFF_WMIX;
  if (l & 1) {
    if (item < 544) conv_tile(smem, p.in[17] + (size_t)j * 1024 * 2120, 1024, 2120, p.in[16] + j * 1024, (bf16_t*)wm, item, 34);
    else conv_tile(smem, p.in[19] + (size_t)j * 1024 * 1024, 1024, 1024, nullptr, (bf16_t*)(wm + 4 * MiB + 512 * 1024), item - 544, 16);
  } else {
    if (item < 384) conv_tile(smem, p.in[3] + (size_t)j * 1024 * 1440, 1024, 1440, p.in[2] + j * 1024, (bf16_t*)wm, item, 24);
    else if (item < 432) conv_tile(smem, p.in[12] + (size_t)j * 256 * 768, 256, 768, p.in[11] + j * 256, (bf16_t*)(wm + 3 * MiB), item - 384, 12);
    else if (item < 464) conv_tile(smem, p.in[14] + (size_t)j * 128 * 1024, 128, 1024, p.in[13] + j * 128, (bf16_t*)(wm + 3 * MiB + 512 * 1024), item - 432, 16);
    else if (item < 720) conv_tile(smem, p.in[15] + (size_t)j * 1024 * 1024, 1024, 1024, nullptr, (bf16_t*)(wm + 4 * MiB), item - 464, 16);
    else if (item < 728) { const int n = item - 720; conv_tile(smem, p.in[6] + ((size_t)j * 8 + n) * 4096, 64, 64, nullptr, (bf16_t*)(wm + 6 * MiB) + n * 4096, 0, 1); }
    else { const int n = item - 728; conv_tile(smem, p.in[8] + ((size_t)j * 8 + n) * 4096, 64, 64, nullptr, (bf16_t*)(wm + 6 * MiB + 65536) + n * 4096, 0, 1); }
  }
}

template <int DQK>
struct QTile { bf16x8 qf[DQK / 16]; f32x16 o0, o1; float m, l; };

template <int DQK>
DI void attn_qt_init(QTile<DQK>& q, const bf16_t* __restrict__ Qrow, int h) {
#pragma unroll
  for (int ks = 0; ks < DQK / 16; ++ks) q.qf[ks] = *(const bf16x8*)(Qrow + ks * 16 + h * 8);
  q.o0 = zero16(); q.o1 = zero16(); q.m = -1e30f; q.l = 0.f;
}

template <int DQK, bool MASK>
DI void attn_qt_step(QTile<DQK>& q, const bf16_t* Ks, const bf16_t* Vs, unsigned mw0, unsigned mw1, int r, int h) {
  constexpr int KST = DQK + 8;
  constexpr int NKS = DQK / 16;
  f32x16 st0 = zero16(), st1 = zero16();
#pragma unroll
  for (int ks = 0; ks < NKS; ++ks) {
    const bf16x8 a0 = *(const bf16x8*)(Ks + r * KST + ks * 16 + h * 8);
    const bf16x8 a1 = *(const bf16x8*)(Ks + (32 + r) * KST + ks * 16 + h * 8);
    st0 = MFMA32(a0, q.qf[ks], st0);
    st1 = MFMA32(a1, q.qf[ks], st1);
  }
  float mx = -1e30f;
#pragma unroll
  for (int i = 0; i < 16; ++i) {
    const int cr = CROW(i, h);
    if (!MASK || ((mw0 >> cr) & 1u)) mx = fmaxf(mx, st0[i]);
    if (!MASK || ((mw1 >> cr) & 1u)) mx = fmaxf(mx, st1[i]);
  }
  mx = fmaxf(mx, __shfl_xor(mx, 32));
  const float mnew = fmaxf(q.m, mx);
  const float alpha = __builtin_amdgcn_exp2f(q.m - mnew);
  q.m = mnew;
  float ps = 0.f;
#pragma unroll
  for (int i = 0; i < 16; ++i) {
    const int cr = CROW(i, h);
    const float p0 = (!MASK || ((mw0 >> cr) & 1u)) ? __builtin_amdgcn_exp2f(st0[i] - mnew) : 0.f;
    const float p1 = (!MASK || ((mw1 >> cr) & 1u)) ? __builtin_amdgcn_exp2f(st1[i] - mnew) : 0.f;
    st0[i] = p0; st1[i] = p1; ps += p0 + p1;
  }
  q.l = q.l * alpha + ps;
#pragma unroll
  for (int i = 0; i < 16; ++i) { q.o0[i] *= alpha; q.o1[i] *= alpha; }
#pragma unroll
  for (int s2 = 0; s2 < 2; ++s2) {
    uint4 pk0, pk1;
    pk0.x = pack2(st0[8 * s2 + 0], st0[8 * s2 + 1]); pk0.y = pack2(st0[8 * s2 + 2], st0[8 * s2 + 3]);
    pk0.z = pack2(st0[8 * s2 + 4], st0[8 * s2 + 5]); pk0.w = pack2(st0[8 * s2 + 6], st0[8 * s2 + 7]);
    pk1.x = pack2(st1[8 * s2 + 0], st1[8 * s2 + 1]); pk1.y = pack2(st1[8 * s2 + 2], st1[8 * s2 + 3]);
    pk1.z = pack2(st1[8 * s2 + 4], st1[8 * s2 + 5]); pk1.w = pack2(st1[8 * s2 + 6], st1[8 * s2 + 7]);
    const bf16x8 pf0 = __builtin_bit_cast(bf16x8, pk0), pf1 = __builtin_bit_cast(bf16x8, pk1);
    {
      const bf16_t* vp = Vs + r * 68 + 16 * s2 + 4 * h;
      const uint2 lo = *(const uint2*)vp, hi = *(const uint2*)(vp + 8);
      const uint2 lo2 = *(const uint2*)(vp + 32 * 68), hi2 = *(const uint2*)(vp + 32 * 68 + 8);
      q.o0 = MFMA32(__builtin_bit_cast(bf16x8, make_uint4(lo.x, lo.y, hi.x, hi.y)), pf0, q.o0);
      q.o1 = MFMA32(__builtin_bit_cast(bf16x8, make_uint4(lo2.x, lo2.y, hi2.x, hi2.y)), pf0, q.o1);
    }
    {
      const bf16_t* vp = Vs + r * 68 + 32 + 16 * s2 + 4 * h;
      const uint2 lo = *(const uint2*)vp, hi = *(const uint2*)(vp + 8);
      const uint2 lo2 = *(const uint2*)(vp + 32 * 68), hi2 = *(const uint2*)(vp + 32 * 68 + 8);
      q.o0 = MFMA32(__builtin_bit_cast(bf16x8, make_uint4(lo.x, lo.y, hi.x, hi.y)), pf1, q.o0);
      q.o1 = MFMA32(__builtin_bit_cast(bf16x8, make_uint4(lo2.x, lo2.y, hi2.x, hi2.y)), pf1, q.o1);
    }
  }
}

template <int DQK>
DI void attn_qt_store(QTile<DQK>& q, bf16_t* __restrict__ orow, int h) {
  const float lt = q.l + __shfl_xor(q.l, 32);
  const float inv = 1.f / lt;
#pragma unroll
  for (int g4 = 0; g4 < 4; ++g4) {
    const int d0 = 8 * g4 + 4 * h;
    uint2 v;
    v.x = pack2(q.o0[4 * g4 + 0] * inv, q.o0[4 * g4 + 1] * inv); v.y = pack2(q.o0[4 * g4 + 2] * inv, q.o0[4 * g4 + 3] * inv);
    *(uint2*)(orow + d0) = v;
    v.x = pack2(q.o1[4 * g4 + 0] * inv, q.o1[4 * g4 + 1] * inv); v.y = pack2(q.o1[4 * g4 + 2] * inv, q.o1[4 * g4 + 3] * inv);
    *(uint2*)(orow + 32 + d0) = v;
  }
}

template <int DQK, int NQT, bool MASK>
DI void attn_core(char* smem, const bf16_t* __restrict__ Kg, const bf16_t* __restrict__ Vtg, const bf16_t* __restrict__ Qw,
                  int nch_blk, int nch_wave, bf16_t* __restrict__ outp, int ostride) {
  constexpr int KST = DQK + 8;
  constexpr int C8 = DQK / 8;
  bf16_t* Ks = (bf16_t*)smem;
  bf16_t* Vs = (bf16_t*)(smem + 13312);
  const unsigned* maskl = (const unsigned*)(smem + 22016);
  const int tid = TIDX(), lane = tid & 63, r = lane & 31, h = lane >> 5;
  QTile<DQK> q0, q1;
  attn_qt_init<DQK>(q0, Qw + (size_t)r * DQK, h);
  if (NQT > 1) attn_qt_init<DQK>(q1, Qw + (size_t)(32 + r) * DQK, h);
  uint4 kr0, kr1, kr2, vr0, vr1;
  const int vd0 = tid >> 3, vc8 = tid & 7;
#define ATTN_GLOAD(kc_)                                                                          \
  {                                                                                              \
    const uint4* kp_ = (const uint4*)(Kg + (size_t)(kc_) * 64 * DQK);                            \
    kr0 = kp_[tid]; kr1 = kp_[tid + 256];                                                        \
    if (DQK == 96) kr2 = kp_[tid + 512];                                                         \
    vr0 = *(const uint4*)(Vtg + (size_t)vd0 * S + (kc_) * 64 + vc8 * 8);                         \
    vr1 = *(const uint4*)(Vtg + (size_t)(vd0 + 32) * S + (kc_) * 64 + vc8 * 8);                  \
  }
  ATTN_GLOAD(0);
  for (int kc = 0; kc < nch_blk; ++kc) {
    __syncthreads();
    {
      { const int e = tid, row = e / C8, c8 = e - row * C8; *(uint4*)(Ks + row * KST + c8 * 8) = kr0; }
      { const int e = tid + 256, row = e / C8, c8 = e - row * C8; *(uint4*)(Ks + row * KST + c8 * 8) = kr1; }
      if (DQK == 96) { const int e = tid + 512, row = e / C8, c8 = e - row * C8; *(uint4*)(Ks + row * KST + c8 * 8) = kr2; }
      uint2* vp = (uint2*)(Vs + vd0 * 68 + vc8 * 8);
      vp[0] = make_uint2(vr0.x, vr0.y); vp[1] = make_uint2(vr0.z, vr0.w);
      vp = (uint2*)(Vs + (vd0 + 32) * 68 + vc8 * 8);
      vp[0] = make_uint2(vr1.x, vr1.y); vp[1] = make_uint2(vr1.z, vr1.w);
    }
    __syncthreads();
    if (kc + 1 < nch_blk) ATTN_GLOAD(kc + 1);
    if (kc < nch_wave) {
      unsigned mw0 = 0xffffffffu, mw1 = 0xffffffffu;
      if (MASK) { mw0 = maskl[r * 65 + 2 * kc]; mw1 = maskl[r * 65 + 2 * kc + 1]; }
      attn_qt_step<DQK, MASK>(q0, Ks, Vs, mw0, mw1, r, h);
      if (NQT > 1) {
        __builtin_amdgcn_sched_barrier(0);
        mw0 = 0xffffffffu; mw1 = 0xffffffffu;
        if (MASK) { mw0 = maskl[(32 + r) * 65 + 2 * kc]; mw1 = maskl[(32 + r) * 65 + 2 * kc + 1]; }
        attn_qt_step<DQK, MASK>(q1, Ks, Vs, mw0, mw1, r, h);
      }
    }
  }
#undef ATTN_GLOAD
  attn_qt_store<DQK>(q0, outp + (size_t)r * ostride, h);
  if (NQT > 1) attn_qt_store<DQK>(q1, outp + (size_t)(32 + r) * ostride, h);
}

DI void lru1_item(const Params& p, char* smem, int j, int item) {
  __syncthreads();
  const int n = item & 7, ch = (item >> 3) & 31, b = item >> 8;
  const int t0 = b * S + ch * 64, c0 = n * 64;
  char* R = p.ws + OFF_R;
  const bf16_t* xr = (const bf16_t*)(R);
  bf16_t* Pg = (bf16_t*)(R + 84 * MiB);
  bf16_t* hl = (bf16_t*)(R + 100 * MiB);
  float* Asum = (float*)(p.ws + OFF_MISC + 2 * MiB);
  float* Bsum = (float*)(p.ws + OFF_MISC + 2 * MiB + 512 * 1024);
  const bf16_t* gaT = (const bf16_t*)(p.ws + OFF_WMIX + 6 * MiB) + n * 4096;
  const bf16_t* gxT = (const bf16_t*)(p.ws + OFF_WMIX + 6 * MiB + 65536) + n * 4096;
  const float* conv_w = p.in[4] + j * 4 * 512;
  const float* conv_b = p.in[5] + j * 512;
  const float* ga_b = p.in[7] + j * 512;
  const float* gx_b = p.in[9] + j * 512;
  const float* lam = p.in[10] + j * 512;
  bf16_t* xcb = (bf16_t*)smem;
  float* av = (float*)(smem + 9216);
  float* bv = (float*)(smem + 25600);
  const int tid = TIDX(), lane = tid & 63, w = tid >> 6, r = lane & 31, h = lane >> 5;
  {
    const int cp = tid & 31, c = c0 + 2 * cp, tb = tid >> 5;
    float2 wq[4];
#pragma unroll
    for (int q = 0; q < 4; ++q) wq[q] = *(const float2*)(conv_w + q * 512 + c);
    const float2 bb = *(const float2*)(conv_b + c);
    unsigned xv[8][4];
#pragma unroll
    for (int it = 0; it < 8; ++it)
#pragma unroll
      for (int q = 0; q < 4; ++q) {
        const int t = tb + 8 * it, sl = ch * 64 + t - 3 + q;
        const int row = (sl >= 0) ? (t0 + t - 3 + q) : t0;
        xv[it][q] = *(const unsigned*)(xr + (size_t)row * 512 + c);
      }
#pragma unroll
    for (int it = 0; it < 8; ++it) {
      const int t = tb + 8 * it;
      float x0 = bb.x, x1 = bb.y;
#pragma unroll
      for (int q = 0; q < 4; ++q) {
        const int sl = ch * 64 + t - 3 + q;
        const unsigned v = (sl >= 0) ? xv[it][q] : 0u;
        x0 += lo2f(v) * wq[q].x; x1 += hi2f(v) * wq[q].y;
      }
      *(float2*)(bv + t * 64 + 2 * cp) = make_float2(x0, x1);
      *(unsigned*)(xcb + t * 72 + 2 * cp) = pack2(x0, x1);
    }
  }
  const int gchan = c0 + 32 * (w & 1) + r;
  const float g_lam = lam[gchan], g_gab = ga_b[gchan], g_gxb = gx_b[gchan];
  __syncthreads();
  {
    const int mt = w >> 1, nt = w & 1;
    f32x16 ga = zero16(), gx = zero16();
#pragma unroll
    for (int ks = 0; ks < 4; ++ks) {
      const bf16x8 a = *(const bf16x8*)(xcb + (32 * mt + r) * 72 + 16 * ks + 8 * h);
      const bf16x8 ba = *(const bf16x8*)(gaT + (32 * nt + r) * 64 + 16 * ks + 8 * h);
      const bf16x8 bx = *(const bf16x8*)(gxT + (32 * nt + r) * 64 + 16 * ks + 8 * h);
      ga = MFMA32(a, ba, ga); gx = MFMA32(a, bx, gx);
    }
    const int c = 32 * nt + r, chan = c0 + c;
    const float el = __expf(-g_lam);
    const float sp = (el < 0.02f) ? el * (1.f - el * (0.5f - el * (0.33333334f - 0.25f * el))) : __logf(1.f + el);
    const float la = -8.f * sp;
    const float gab = g_gab, gxb = g_gxb;
#pragma unroll
    for (int i = 0; i < 16; ++i) {
      const int t = 32 * mt + CROW(i, h);
      const float rg = sigmoidf_(ga[i] + gab), ig = sigmoidf_(gx[i] + gxb);
      const float log_a = la * rg;
      const float a = __expf(log_a);
      const float mult = sqrtf(fmaxf(1.f - a * a, 0.f));
      const float xcv = bv[t * 64 + c];
      av[t * 64 + c] = a;
      bv[t * 64 + c] = mult * ig * xcv;
    }
  }
  __syncthreads();
  {
    const int c = tid & 63, q = tid >> 6;
    float A = 1.f, H = 0.f;
    const int tend = 16 * q + 16;
#pragma unroll 4
    for (int t = 0; t < tend; ++t) {
      const float a = av[t * 64 + c];
      H = a * H + bv[t * 64 + c];
      A *= a;
      if (t >= 16 * q) {
        hl[(size_t)(t0 + t) * 512 + c0 + c] = f2bf(H);
        Pg[(size_t)(t0 + t) * 512 + c0 + c] = f2bf(A);
      }
    }
    if (q == 3) { Asum[(b * 32 + ch) * 512 + c0 + c] = A; Bsum[(b * 32 + ch) * 512 + c0 + c] = H; }
  }
}

DI void lru2_item(const Params& p, char* smem, int item) {
  __syncthreads();
  const int ch = item & 31, b = item >> 5;
  char* R = p.ws + OFF_R;
  const bf16_t* gg = (const bf16_t*)(R + 16 * MiB);
  const bf16_t* Pg = (const bf16_t*)(R + 84 * MiB);
  bf16_t* hl = (bf16_t*)(R + 100 * MiB);
  const float* Asum = (const float*)(p.ws + OFF_MISC + 2 * MiB);
  const float* Bsum = (const float*)(p.ws + OFF_MISC + 2 * MiB + 512 * 1024);
  float* carry = (float*)smem;
  const int tid = TIDX();
#pragma unroll
  for (int k = 0; k < 2; ++k) {
    const int c = tid + 256 * k;
    float H = 0.f;
    for (int q0 = 0; q0 < ch; q0 += 8) {
      float ca[8], cb2[8];
#pragma unroll
      for (int u = 0; u < 8; ++u) { const int q = (q0 + u < 32) ? (q0 + u) : 31; ca[u] = Asum[(b * 32 + q) * 512 + c]; cb2[u] = Bsum[(b * 32 + q) * 512 + c]; }
#pragma unroll
      for (int u = 0; u < 8; ++u) { const bool on = (q0 + u) < ch; H = (on ? ca[u] : 1.f) * H + (on ? cb2[u] : 0.f); }
    }
    carry[c] = H;
  }
  __syncthreads();
  const size_t base = (size_t)(b * S + ch * 64) * 512;
#pragma unroll 1
  for (int it0 = 0; it0 < 64; it0 += 16) {
    unsigned hv[16], pv[16], gv[16];
#pragma unroll
    for (int u = 0; u < 16; ++u) {
      const int e = tid + 256 * (it0 + u);
      const size_t off = base + (size_t)(e >> 8) * 512 + 2 * (e & 255);
      hv[u] = *(const unsigned*)(hl + off); pv[u] = *(const unsigned*)(Pg + off); gv[u] = *(const unsigned*)(gg + off);
    }
#pragma unroll
    for (int u = 0; u < 16; ++u) {
      const int e = tid + 256 * (it0 + u);
      const int c = 2 * (e & 255);
      const size_t off = base + (size_t)(e >> 8) * 512 + c;
      const float y0 = (lo2f(hv[u]) + lo2f(pv[u]) * carry[c]) * lo2f(gv[u]);
      const float y1 = (hi2f(hv[u]) + hi2f(pv[u]) * carry[c + 1]) * hi2f(gv[u]);
      *(unsigned*)(hl + off) = pack2(y0, y1);
    }
  }
}

DI unsigned tokey(float f) { unsigned u = __float_as_uint(f + 0.0f); return (u & 0x80000000u) ? ~u : (u | 0x80000000u); }

DI int tk_cnt(const int* hist, int hq, int bin) {
  return hist[(0 * 16 + hq) * 256 + bin] + hist[(1 * 16 + hq) * 256 + bin] + hist[(2 * 16 + hq) * 256 + bin] + hist[(3 * 16 + hq) * 256 + bin];
}
DI void tk_scan(const int* hist, int* res, int hq, int hl, int K) {
  int psum = 0;
#pragma unroll
  for (int x = 0; x < 16; ++x) psum += tk_cnt(hist, hq, 16 * hl + x);
  int inc = psum;
#pragma unroll
  for (int d = 1; d < 16; d <<= 1) { const int t = __shfl_up(inc, d, 16); if (hl >= d) inc += t; }
  const int e = inc - psum;
  if (e < K && K <= inc) {
    int run = e, found = 0, fb = 0, fk = 0, fc = 0;
    for (int x = 0; x < 16; ++x) {
      const int cnt = tk_cnt(hist, hq, 16 * hl + x);
      if (!found && K <= run + cnt) { found = 1; fb = 16 * hl + x; fk = K - run; fc = cnt; }
      run += cnt;
    }
    res[hq * 4 + 0] = fb; res[hq * 4 + 1] = fk; res[hq * 4 + 2] = fc;
  }
}

DI void topk_item(const Params& p, char* smem, int item) {
  __syncthreads();
  const int qq = item & 3, rest = item >> 2, b = rest & 7, c = 31 - (rest >> 3);
  const int q0 = c * 64 + qq * 16;
  const int ntw = c + 1;
  char* R = p.ws + OFF_R;
  const bf16_t* qi = (const bf16_t*)(R + 48 * MiB);
  const bf16_t* kib = (const bf16_t*)(R + 64 * MiB);
  unsigned* sel = (unsigned*)(R + 66 * MiB);
  const float* wif = (const float*)(p.ws + OFF_MISC + 3 * MiB);
  const int blk = blockIdx.x;
  unsigned* scr = (unsigned*)((blk < 256) ? (p.ws + OFF_X + (size_t)blk * 131072) : (R + 70 * MiB + (size_t)(blk - 256) * 131072));
  int* hist = (int*)smem;
  bf16_t* qs = (bf16_t*)(smem + 16384);
  int* res = (int*)(smem + 65600);
  const int tid = TIDX(), lane = tid & 63, w = tid >> 6, qn = lane & 15, g = lane >> 4;
#pragma unroll
  for (int it = 0; it < 4; ++it) {
    const int e = tid + 256 * it, hd = e >> 7, rem = e & 127, q = rem >> 3, c8 = rem & 7;
    const uint4 v = *(const uint4*)(qi + ((size_t)(b * 8 + hd) * S + q0 + q) * 64 + c8 * 8);
    *(uint4*)(qs + (hd * 16 + q) * 72 + c8 * 8) = v;
  }
  __syncthreads();
  {
    float wq0, wq1, wq2, wq3, wq4, wq5, wq6, wq7;
    const float4* wp = (const float4*)(wif + (size_t)(b * S + q0 + qn) * 8);
    const float4 wa = wp[0], wb = wp[1];
    wq0 = wa.x; wq1 = wa.y; wq2 = wa.z; wq3 = wa.w; wq4 = wb.x; wq5 = wb.y; wq6 = wb.z; wq7 = wb.w;
    const bf16_t* qsl = qs + qn * 72 + 8 * g;
#define TK_HEAD(hd_, wq_)                                                                         \
  {                                                                                               \
    const bf16x8 f0_ = *(const bf16x8*)(qsl + (hd_) * 16 * 72), f1_ = *(const bf16x8*)(qsl + (hd_) * 16 * 72 + 32); \
    f32x4 s_ = MFMA16(a0, f0_, z);                                                                \
    s_ = MFMA16(a1, f1_, s_);                                                                     \
    acc0 += (wq_) * fmaxf(s_[0], 0.f); acc1 += (wq_) * fmaxf(s_[1], 0.f);                         \
    acc2 += (wq_) * fmaxf(s_[2], 0.f); acc3 += (wq_) * fmaxf(s_[3], 0.f);                         \
  }
#pragma unroll 1
    for (int jt0 = 0; jt0 < ntw; jt0 += 4) {
      bf16x8 ka0[4], ka1[4];
#pragma unroll
      for (int u = 0; u < 4; ++u) {
        const int jt = (jt0 + u < ntw) ? (jt0 + u) : (ntw - 1);
        const bf16_t* kp = kib + (size_t)(b * S + 16 * (w + 4 * jt) + qn) * 64 + 8 * g;
        ka0[u] = *(const bf16x8*)kp; ka1[u] = *(const bf16x8*)(kp + 32);
      }
#pragma unroll
      for (int u = 0; u < 4; ++u) {
        if (jt0 + u < ntw) {
          const int kt = w + 4 * (jt0 + u);
          const bf16x8 a0 = ka0[u], a1 = ka1[u];
          const f32x4 z = {0.f, 0.f, 0.f, 0.f};
          float acc0 = 0.f, acc1 = 0.f, acc2 = 0.f, acc3 = 0.f;
          TK_HEAD(0, wq0) TK_HEAD(1, wq1) TK_HEAD(2, wq2) TK_HEAD(3, wq3)
          TK_HEAD(4, wq4) TK_HEAD(5, wq5) TK_HEAD(6, wq6) TK_HEAD(7, wq7)
          uint4 o; o.x = tokey(acc0); o.y = tokey(acc1); o.z = tokey(acc2); o.w = tokey(acc3);
          *(uint4*)(scr + qn * 2048 + 16 * kt + 4 * g) = o;
        }
      }
    }
#undef TK_HEAD
  }
  __syncthreads();
  const int hq = tid >> 4, hl = tid & 15;
  const unsigned* srow = scr + hq * 2048 + 4 * hl;
  uint4 kv[32];
#pragma unroll
  for (int j = 0; j < 32; ++j) kv[j] = (j < ntw) ? *(const uint4*)(srow + 64 * j) : make_uint4(0u, 0u, 0u, 0u);
  int* hcp = hist + ((hl & 3) * 16 + hq) * 256;
#define TK_ZERO_HIST() { _Pragma("unroll") for (int it = 0; it < 16; ++it) ((uint4*)hist)[tid + 256 * it] = make_uint4(0u, 0u, 0u, 0u); }
#define TK_FOREACH(BODY)                                                                   \
  _Pragma("unroll") for (int j = 0; j < 32; ++j) {                                         \
    if (j < ntw) {                                                                         \
      const unsigned uu_[4] = {kv[j].x, kv[j].y, kv[j].z, kv[j].w};                        \
      _Pragma("unroll") for (int e = 0; e < 4; ++e) { const unsigned u = uu_[e]; const int idx = 64 * j + 4 * hl + e; (void)idx; BODY }  \
    }                                                                                      \
  }
  unsigned prefix = 0;
  int Krem = 256, ceq = 0;
#pragma unroll 1
  for (int pass = 0; pass < 4; ++pass) {
    const int shift = 24 - 8 * pass;
    __syncthreads();
    TK_ZERO_HIST();
    __syncthreads();
    const unsigned pmask = (pass == 0) ? 0u : (0xffffffffu << (shift + 8));
    const unsigned pval = prefix << ((shift + 8) & 31);
    TK_FOREACH( if ((u & pmask) == (pval & pmask)) atomicAdd(&hcp[255 - ((u >> shift) & 255u)], 1); )
    __syncthreads();
    tk_scan(hist, res, hq, hl, Krem);
    __syncthreads();
    prefix = (prefix << 8) | (unsigned)(255 - res[hq * 4 + 0]);
    Krem = res[hq * 4 + 1];
    ceq = res[hq * 4 + 2];
  }
  const unsigned Tq = prefix;
  const int need = Krem;
  int Jlast = 4095;
  if (__syncthreads_or(ceq != need)) {
    TK_ZERO_HIST();
    __syncthreads();
    TK_FOREACH( if (u == Tq) atomicAdd(&hcp[idx >> 3], 1); )
    __syncthreads();
    tk_scan(hist, res, hq, hl, need);
    __syncthreads();
    const int binB = res[hq * 4 + 0], k2 = res[hq * 4 + 1];
    __syncthreads();
    TK_ZERO_HIST();
    __syncthreads();
    TK_FOREACH( if (u == Tq && (idx >> 3) == binB) atomicAdd(&hcp[idx & 7], 1); )
    __syncthreads();
    tk_scan(hist, res, hq, hl, k2);
    __syncthreads();
    Jlast = binB * 8 + res[hq * 4 + 0];
  }
#pragma unroll
  for (int j = 0; j < 32; ++j) {
    if (j < ntw) {
      const unsigned uu_[4] = {kv[j].x, kv[j].y, kv[j].z, kv[j].w};
      unsigned word = 0;
#pragma unroll
      for (int e = 0; e < 4; ++e) {
        const int idx = 64 * j + 4 * hl + e;
        const bool sl = (uu_[e] > Tq) || (uu_[e] == Tq && idx <= Jlast);
        word |= sl ? (1u << ((hl & 7) * 4 + e)) : 0u;
      }
      word |= __shfl_xor(word, 1); word |= __shfl_xor(word, 2); word |= __shfl_xor(word, 4);
      if ((hl & 7) == 0) sel[(size_t)(b * S + q0 + hq) * 64 + 2 * j + (hl >> 3)] = word;
    }
  }
#undef TK_FOREACH
#undef TK_ZERO_HIST
}

DI void phase_prologue(const Params& p, char* smem) {
  const int nb = gridDim.x, bid = blockIdx.x, tid = TIDX();
  const float* x = p.in[0];
  bf16_t* xb = (bf16_t*)(p.ws + OFF_XB);
  float* cs = (float*)(p.ws + OFF_MISC);
  const int n_xb = T * 1024 / 8192, n_cs = T * 16 / 256, n_cv = conv_mix_count(0);
  for (int it = bid; it < n_xb + n_cs + n_cv; it += nb) {
    if (it < n_xb) {
      float4 v0[4], v1[4];
#pragma unroll
      for (int u = 0; u < 4; ++u) { const size_t e = (size_t)it * 8192 + u * 2048 + tid * 8; v0[u] = *(const float4*)(x + e); v1[u] = *(const float4*)(x + e + 4); }
#pragma unroll
      for (int u = 0; u < 4; ++u) {
        const size_t e = (size_t)it * 8192 + u * 2048 + tid * 8;
        uint4 o; o.x = pack2(v0[u].x, v0[u].y); o.y = pack2(v0[u].z, v0[u].w); o.z = pack2(v1[u].x, v1[u].y); o.w = pack2(v1[u].z, v1[u].w);
        *(uint4*)(xb + e) = o;
      }
    } else if (it < n_xb + n_cs) {
      const int e = (it - n_xb) * 256 + tid, t = e >> 4, jf = e & 15;
      const float freq = __builtin_amdgcn_exp2f(-(float)jf * 0.8304820237218406f);
      const float ang = (float)p.pos[t] * freq;
      double rev = (double)ang * 0.15915494309189535;
      rev -= floor(rev);
      const float rf = (float)rev;
      cs[t * 32 + jf] = __builtin_amdgcn_cosf(rf);
      cs[t * 32 + 16 + jf] = __builtin_amdgcn_sinf(rf);
    } else {
      conv_mix_item(p, smem, 0, it - n_xb - n_cs);
    }
  }
}

DI void phase_final(const Params& p) {
  const float* x = (const float*)(p.ws + OFF_X);
  const float* g = p.in[23];
  const int lane = TIDX() & 63, w = TIDX() >> 6;
  float4 gv[4];
#pragma unroll
  for (int q = 0; q < 4; ++q) gv[q] = *(const float4*)(g + (lane + 64 * q) * 4);
  for (int row0 = (blockIdx.x * 4 + w) * 4; row0 < T; row0 += gridDim.x * 16) {
    float4 v[4][4];
#pragma unroll
    for (int rr = 0; rr < 4; ++rr)
#pragma unroll
      for (int q = 0; q < 4; ++q) v[rr][q] = *(const float4*)(x + (size_t)(row0 + rr) * 1024 + (lane + 64 * q) * 4);
#pragma unroll
    for (int rr = 0; rr < 4; ++rr) {
      float ss = 0.f;
#pragma unroll
      for (int q = 0; q < 4; ++q) ss += v[rr][q].x * v[rr][q].x + v[rr][q].y * v[rr][q].y + v[rr][q].z * v[rr][q].z + v[rr][q].w * v[rr][q].w;
#pragma unroll
      for (int o = 1; o < 64; o <<= 1) ss += __shfl_xor(ss, o);
      const float rstd = rsqrtf(ss * (1.f / 1024.f) + EPSV);
#pragma unroll
      for (int q = 0; q < 4; ++q) {
        float4 o; o.x = v[rr][q].x * rstd * gv[q].x; o.y = v[rr][q].y * rstd * gv[q].y; o.z = v[rr][q].z * rstd * gv[q].z; o.w = v[rr][q].w * rstd * gv[q].w;
        *(float4*)(p.out + (size_t)(row0 + rr) * 1024 + (lane + 64 * q) * 4) = o;
      }
    }
  }
}

struct EpiResid {
  const float* xin;
  float* xout;
  bf16_t* xb;
  DI void operator()(int rb, int cb, const f32x16& c0, const f32x16& c1, const float*) const {
    const int lane = TIDX() & 63, r = lane & 31, h = lane >> 5;
    bf16_t r0[16], r1[16];
#pragma unroll
    for (int i = 0; i < 16; ++i) { const size_t o = (size_t)(rb + CROW(i, h)) * 1024 + cb + r; r0[i] = xb[o]; r1[i] = xb[o + 32]; }
    __builtin_amdgcn_sched_barrier(0);
    float x0[16], x1[16];
#pragma unroll
    for (int i = 0; i < 16; ++i) { x0[i] = bf2f(r0[i]); x1[i] = bf2f(r1[i]); }
#pragma unroll
    for (int i = 0; i < 16; ++i) {
      const size_t o = (size_t)(rb + CROW(i, h)) * 1024 + cb + r;
      const float v0 = x0[i] + c0[i], v1 = x1[i] + c1[i];
      if (xout) { xout[o] = v0; xout[o + 32] = v1; }
      xb[o] = f2bf(v0); xb[o + 32] = f2bf(v1);
    }
  }
};

DI void phase_resid_gemm(const Params& p, char* smem, const bf16_t* a0, int lda0, const bf16_t* a1, int lda1, int ksplit,
                         const bf16_t* Wt, int K, const float* xin, bool write_f32) {
  EpiResid epi{xin, write_f32 ? (float*)(p.ws + OFF_X) : nullptr, (bf16_t*)(p.ws + OFF_XB)};
  if (ksplit >= K) {
    for (int it = blockIdx.x; it < 512; it += gridDim.x) {
      const int nt = (it >> 3) & 7, mt = ((it >> 6) << 3) | (it & 7);
      gemm_tile_big<false>(smem, a0, lda0, Wt, K, mt * 256, nt * 128, 0.f, epi);
    }
  } else {
    for (int it = blockIdx.x; it < 512; it += gridDim.x) {
      const int nt = (it >> 3) & 7, mt = ((it >> 6) << 3) | (it & 7);
      gemm_tile_big<false>(smem, a0, lda0, Wt, K, mt * 256, nt * 128, 0.f, epi, a1, ksplit);
    }
  }
}

DI void phase_E1(const Params& p, char* smem, int l) {
  char* R = p.ws + OFF_R;
  bf16_t* xr = (bf16_t*)R; bf16_t* gg = (bf16_t*)(R + 16 * MiB); bf16_t* cqb = (bf16_t*)(R + 32 * MiB); bf16_t* ckvb = (bf16_t*)(R + 40 * MiB);
  bf16_t* Kb = (bf16_t*)(R + 44 * MiB);
  const float* cs = (const float*)(p.ws + OFF_MISC);
  const bf16_t* xb = (const bf16_t*)(p.ws + OFF_XB);
  const bf16_t* Wt = (const bf16_t*)(p.ws + OFF_WMIX);
  auto epi = [=](int rb, int cb, const f32x16& c0, const f32x16& c1, const float* rsp) __attribute__((always_inline)) {
    const int lane = TIDX() & 63, r = lane & 31, h = lane >> 5;
    if (cb < 512) {
#pragma unroll
      for (int i = 0; i < 16; ++i) { const int cr = CROW(i, h); const float s = rsp[cr]; const size_t o = (size_t)(rb + cr) * 512 + cb + r; xr[o] = f2bf(c0[i] * s); xr[o + 32] = f2bf(c1[i] * s); }
    } else if (cb < 1024) {
#pragma unroll
      for (int i = 0; i < 16; ++i) { const int cr = CROW(i, h); const float s = rsp[cr]; const size_t o = (size_t)(rb + cr) * 512 + (cb - 512) + r; gg[o] = f2bf(gelu_tanh(c0[i] * s)); gg[o + 32] = f2bf(gelu_tanh(c1[i] * s)); }
    } else if (cb < 1280) {
#pragma unroll
      for (int i = 0; i < 16; ++i) { const int cr = CROW(i, h); const float s = rsp[cr]; const size_t o = (size_t)(rb + cr) * 256 + (cb - 1024) + r; cqb[o] = f2bf(c0[i] * s); cqb[o + 32] = f2bf(c1[i] * s); }
    } else if (cb < 1408) {
#pragma unroll
      for (int i = 0; i < 16; ++i) { const int cr = CROW(i, h); const float s = rsp[cr]; const size_t o = (size_t)(rb + cr) * 128 + (cb - 1280) + r; ckvb[o] = f2bf(c0[i] * s); ckvb[o + 32] = f2bf(c1[i] * s); }
    } else if (cb == 1408) {
      float ccv[16], snv[16];
#pragma unroll
      for (int i = 0; i < 16; ++i) { const int row = rb + CROW(i, h); ccv[i] = cs[row * 32 + (r & 15)]; snv[i] = cs[row * 32 + 16 + (r & 15)]; }
#pragma unroll
      for (int i = 0; i < 16; ++i) {
        const int cr = CROW(i, h); const int row = rb + cr;
        const float v = c0[i] * rsp[cr];
        const float pv = __shfl_xor(v, 16);
        const float cc = ccv[i], sn = snv[i];
        const float o = (r < 16) ? (v * cc - pv * sn) : (pv * sn + v * cc);
        const int b = row >> 11, s = row & 2047;
        const bf16_t ob = f2bf(o);
#pragma unroll
        for (int hd = 0; hd < 8; ++hd) Kb[((size_t)(b * 8 + hd) * S + s) * 96 + 64 + r] = ob;
      }
    }
  };
  const int ng = 1024;
  for (int it = blockIdx.x; it < ng; it += gridDim.x) {
    if (it < 512) { const int nt = (it >> 3) & 7, mt = ((it >> 6) << 3) | (it & 7); gemm_tile_big<true>(smem, xb, 1024, Wt, 1024, mt * 256, nt * 128, 1.f / 1024.f, epi); }
    else { const int i2 = it - 512; const int nt = 8 + (i2 >> 7), mt = i2 & 127; gemm_tile<true>(smem, xb, 1024, xb, 1024, 1 << 30, Wt, 1024, mt * 128, nt * 128, 1.f / 1024.f, epi); }
  }
}

DI void phase_E2(const Params& p, char* smem, int l) {
  char* R = p.ws + OFF_R;
  const bf16_t* cqb = (const bf16_t*)(R + 32 * MiB); const bf16_t* ckvb = (const bf16_t*)(R + 40 * MiB);
  bf16_t* Qb = (bf16_t*)(p.ws + OFF_X);
  bf16_t* Kb = (bf16_t*)(R + 44 * MiB); bf16_t* Vt = (bf16_t*)(R + 68 * MiB);
  const float* cs = (const float*)(p.ws + OFF_MISC);
  const bf16_t* WuqT = (const bf16_t*)(p.ws + OFF_WMIX + 3 * MiB);
  const bf16_t* WukvT = (const bf16_t*)(p.ws + OFF_WMIX + 3 * MiB + 512 * 1024);
  const float qscale = 0.10206207261596575f * LOG2E;
  auto epi_q = [=](int rb, int cb, const f32x16& c0, const f32x16& c1, const float* rsp) __attribute__((always_inline)) {
    const int lane = TIDX() & 63, r = lane & 31, h = lane >> 5;
#pragma unroll
    for (int ni = 0; ni < 2; ++ni) {
      const int col = cb + 32 * ni + r;
      const int hd = col / 96, dd = col - hd * 96;
      const bool rope = (((cb >> 5) + ni) % 3) == 2;
#pragma unroll
      for (int i0 = 0; i0 < 16; i0 += 8) {
      float ccv[8], snv[8];
      if (rope) {
#pragma unroll
        for (int i = 0; i < 8; ++i) { const int row = rb + CROW(i0 + i, h); ccv[i] = cs[row * 32 + (r & 15)]; snv[i] = cs[row * 32 + 16 + (r & 15)]; }
      }
#pragma unroll
      for (int i = i0; i < i0 + 8; ++i) {
        const int cr = CROW(i, h); const int row = rb + cr;
        float v = (ni ? c1[i] : c0[i]) * rsp[cr];
        if (rope) {
          const float pv = __shfl_xor(v, 16);
          const float cc = ccv[i - i0], sn = snv[i - i0];
          v = (r < 16) ? (v * cc - pv * sn) : (pv * sn + v * cc);
        }
        const int b = row >> 11, s = row & 2047;
        Qb[((size_t)(b * 8 + hd) * S + s) * 96 + dd] = f2bf(v * qscale);
      }
      }
    }
  };
  auto epi_kv = [=](int rb, int cb, const f32x16& c0, const f32x16& c1, const float* rsp) __attribute__((always_inline)) {
    const int lane = TIDX() & 63, r = lane & 31, h = lane >> 5;
    const int hd = cb >> 7;
    const int b = rb >> 11, s0 = rb & 2047;
    if ((cb & 127) < 64) {
#pragma unroll
      for (int i = 0; i < 16; ++i) {
        const int cr = CROW(i, h); const float sc = rsp[cr];
        const size_t o = ((size_t)(b * 8 + hd) * S + s0 + cr) * 96 + (cb & 127) + r;
        Kb[o] = f2bf(c0[i] * sc); Kb[o + 32] = f2bf(c1[i] * sc);
      }
    } else {
#pragma unroll
      for (int ni = 0; ni < 2; ++ni) {
        const int dd = (cb & 127) - 64 + 32 * ni + r;
#pragma unroll
        for (int g4 = 0; g4 < 4; ++g4) {
          const int cr = 8 * g4 + 4 * h;
          float v[4];
#pragma unroll
          for (int q = 0; q < 4; ++q) v[q] = (ni ? c1[4 * g4 + q] : c0[4 * g4 + q]) * rsp[cr + q];
          uint2 o; o.x = pack2(v[0], v[1]); o.y = pack2(v[2], v[3]);
          *(uint2*)(Vt + ((size_t)(b * 8 + hd) * 64 + dd) * S + s0 + cr) = o;
        }
      }
    }
  };
  const int nq = 128 * 6, nkv = 128 * 8, nl = 2048;
  for (int it = blockIdx.x; it < nq + nkv + nl + CONV_MLP_ITEMS; it += gridDim.x) {
    if (it >= nq + nkv + nl) { conv_mlp_item(p, smem, l, it - nq - nkv - nl); continue; }
    if (it < nq) { const int nt = it >> 7, mt = it & 127; gemm_tile<true>(smem, cqb, 256, cqb, 256, 1 << 30, WuqT, 256, mt * 128, nt * 128, 1.f / 256.f, epi_q); }
    else if (it < nq + nkv) { const int i2 = it - nq; const int nt = i2 >> 7, mt = i2 & 127; gemm_tile<true>(smem, ckvb, 128, ckvb, 128, 1 << 30, WukvT, 128, mt * 128, nt * 128, 1.f / 128.f, epi_kv); }
    else lru1_item(p, smem, l >> 1, it - nq - nkv);
  }
}

DI void phase_E3(const Params& p, char* smem) {
  char* R = p.ws + OFF_R;
  const bf16_t* Qb = (const bf16_t*)(p.ws + OFF_X);
  const bf16_t* Kb = (const bf16_t*)(R + 44 * MiB); const bf16_t* Vt = (const bf16_t*)(R + 68 * MiB);
  bf16_t* ymla = (bf16_t*)R;
  const int w = TIDX() >> 6;
  for (int it0 = blockIdx.x; it0 < 1024 + 256; it0 += gridDim.x) {
    const int pos = it0 - 256;
    const int it = (it0 < 256) ? (1024 + it0) : ((pos < 512) ? pos : (1535 - pos));
    if (it < 1024) {
      const int qb = 15 - (it >> 6), bh = it & 63, b = bh >> 3, hd = bh & 7;
      const bf16_t* Kg = Kb + (size_t)bh * S * 96;
      const bf16_t* Vg = Vt + (size_t)bh * 64 * S;
      const bf16_t* Qw = Qb + ((size_t)bh * S + qb * 128 + w * 32) * 96;
      bf16_t* op = ymla + (size_t)(b * S + qb * 128 + w * 32) * 512 + hd * 64;
      attn_core<96, 1, false>(smem, Kg, Vg, Qw, 2 * qb + 2, 2 * qb + 1 + (w >> 1), op, 512);
    } else lru2_item(p, smem, it - 1024);
  }
}

DI void phase_O1(const Params& p, char* smem, int l) {
  char* R = p.ws + OFF_R;
  bf16_t* Qd = (bf16_t*)R; bf16_t* Kd = (bf16_t*)(R + 32 * MiB); bf16_t* Vdt = (bf16_t*)(R + 40 * MiB);
  bf16_t* qi = (bf16_t*)(R + 48 * MiB); bf16_t* kib = (bf16_t*)(R + 64 * MiB);
  float* wif = (float*)(p.ws + OFF_MISC + 3 * MiB);
  const float* gk = p.in[18] + (l >> 1) * 64;
  const bf16_t* xb = (const bf16_t*)(p.ws + OFF_XB);
  const bf16_t* Wt = (const bf16_t*)(p.ws + OFF_WMIX);
  const float dscale = 0.125f * LOG2E;
  const float wscale = 0.35355339059327373f * 0.125f;
  auto epi = [=](int rb, int cb, const f32x16& c0, const f32x16& c1, const float* rsp) __attribute__((always_inline)) {
    const int lane = TIDX() & 63, r = lane & 31, h = lane >> 5;
    const int b = rb >> 11, s0 = rb & 2047;
    if (cb < 1024) {
      const int hd = cb >> 6;
#pragma unroll
      for (int i = 0; i < 16; ++i) { const int cr = CROW(i, h); const float sc = rsp[cr] * dscale; const size_t o = ((size_t)(b * 16 + hd) * S + s0 + cr) * 64 + r; Qd[o] = f2bf(c0[i] * sc); Qd[o + 32] = f2bf(c1[i] * sc); }
    } else if (cb < 1280) {
      const int g = (cb - 1024) >> 6;
#pragma unroll
      for (int i = 0; i < 16; ++i) { const int cr = CROW(i, h); const float sc = rsp[cr]; const size_t o = ((size_t)(b * 4 + g) * S + s0 + cr) * 64 + r; Kd[o] = f2bf(c0[i] * sc); Kd[o + 32] = f2bf(c1[i] * sc); }
    } else if (cb < 1536) {
      const int g = (cb - 1280) >> 6;
#pragma unroll
      for (int ni = 0; ni < 2; ++ni) {
        const int dd = 32 * ni + r;
#pragma unroll
        for (int g4 = 0; g4 < 4; ++g4) {
          const int cr = 8 * g4 + 4 * h;
          float v[4];
#pragma unroll
          for (int q = 0; q < 4; ++q) v[q] = (ni ? c1[4 * g4 + q] : c0[4 * g4 + q]) * rsp[cr + q];
          uint2 o; o.x = pack2(v[0], v[1]); o.y = pack2(v[2], v[3]);
          *(uint2*)(Vdt + ((size_t)(b * 4 + g) * 64 + dd) * S + s0 + cr) = o;
        }
      }
    } else if (cb < 2048) {
      const int hi = (cb - 1536) >> 6;
#pragma unroll
      for (int i = 0; i < 16; ++i) { const int cr = CROW(i, h); const float sc = rsp[cr]; const size_t o = ((size_t)(b * 8 + hi) * S + s0 + cr) * 64 + r; qi[o] = f2bf(c0[i] * sc); qi[o + 32] = f2bf(c1[i] * sc); }
    } else if (cb == 2048) {
      const float g0 = gk[r], g1 = gk[32 + r];
#pragma unroll
      for (int i = 0; i < 16; ++i) {
        const int cr = CROW(i, h); const float sc = rsp[cr];
        const float v0 = c0[i] * sc, v1 = c1[i] * sc;
        float ss = v0 * v0 + v1 * v1;
        ss += __shfl_xor(ss, 1); ss += __shfl_xor(ss, 2); ss += __shfl_xor(ss, 4); ss += __shfl_xor(ss, 8); ss += __shfl_xor(ss, 16);
        const float rk = rsqrtf(ss * (1.f / 64.f) + EPSV);
        const size_t o = (size_t)(rb + cr) * 64 + r;
        kib[o] = f2bf(v0 * rk * g0); kib[o + 32] = f2bf(v1 * rk * g1);
      }
    } else if (cb == 2112) {
      if (r < 8) {
#pragma unroll
        for (int i = 0; i < 16; ++i) { const int cr = CROW(i, h); wif[(size_t)(rb + cr) * 8 + r] = c0[i] * rsp[cr] * wscale; }
      }
    }
  };
  const int ng = 1024 + 128;
  for (int it = blockIdx.x; it < ng + CONV_MLP_ITEMS; it += gridDim.x) {
    if (it < 1024) { const int i9 = it & 511; const int nt = ((it >> 9) << 3) | ((i9 >> 3) & 7), mt = ((i9 >> 6) << 3) | (i9 & 7); gemm_tile_big<true>(smem, xb, 1024, Wt, 1024, mt * 256, nt * 128, 1.f / 1024.f, epi); }
    else if (it < ng) { const int mt = it - 1024; gemm_tile<true>(smem, xb, 1024, xb, 1024, 1 << 30, Wt, 1024, mt * 128, 16 * 128, 1.f / 1024.f, epi); }
    else conv_mlp_item(p, smem, l, it - ng);
  }
}

DI void phase_O3(const Params& p, char* smem) {
  char* R = p.ws + OFF_R;
  const bf16_t* Qd = (const bf16_t*)R; const bf16_t* Kd = (const bf16_t*)(R + 32 * MiB); const bf16_t* Vdt = (const bf16_t*)(R + 40 * MiB);
  const unsigned* sel = (const unsigned*)(R + 66 * MiB);
  bf16_t* yd = (bf16_t*)(R + 70 * MiB);
  unsigned* maskl = (unsigned*)(smem + 22016);
  const int tid = TIDX(), w = tid >> 6;
  for (int it0 = blockIdx.x; it0 < 1024; it0 += gridDim.x) {
    const int it = (it0 < 512) ? it0 : (1535 - it0);
    const int c = 31 - (it >> 5), bg = it & 31, b = bg >> 2, g = bg & 3;
    const bool use_mask = c >= 4;
    __syncthreads();
    {
      const int nw = 2 * (c + 1);
      unsigned mv[16];
#pragma unroll
      for (int i = 0; i < 16; ++i) { const int e = tid + 256 * i, q = e >> 6, wd = e & 63; mv[i] = (use_mask && wd < nw) ? sel[(size_t)(b * S + c * 64 + q) * 64 + wd] : 0xffffffffu; }
#pragma unroll
      for (int i = 0; i < 16; ++i) { const int e = tid + 256 * i, q = e >> 6, wd = e & 63; if (wd < nw) maskl[q * 65 + wd] = mv[i]; }
    }
    const int head = 4 * g + w;
    const bf16_t* Kg = Kd + (size_t)bg * S * 64;
    const bf16_t* Vg = Vdt + (size_t)bg * 64 * S;
    const bf16_t* Qw = Qd + ((size_t)(b * 16 + head) * S + c * 64) * 64;
    bf16_t* op = yd + (size_t)(b * S + c * 64) * 1024 + head * 64;
    attn_core<64, 2, true>(smem, Kg, Vg, Qw, c + 1, c + 1, op, 1024);
  }
}

DI void phase_M1(const Params& p, char* smem, int l) {
  const bf16_t* xb = (const bf16_t*)(p.ws + OFF_XB);
  const bf16_t* W1t = (const bf16_t*)(p.ws + OFF_WMLP);
  bf16_t* a = (bf16_t*)(p.ws + OFF_R);
  auto epi = [=](int rb, int cb, const f32x16& c0, const f32x16& c1, const float* rsp) __attribute__((always_inline)) {
    const int lane = TIDX() & 63, r = lane & 31, h = lane >> 5;
#pragma unroll
    for (int i = 0; i < 16; ++i) {
      const int cr = CROW(i, h); const float sc = rsp[cr];
      const size_t o = (size_t)(rb + cr) * 4096 + cb + r;
      const float v0 = fmaxf(c0[i] * sc, 0.f), v1 = fmaxf(c1[i] * sc, 0.f);
      a[o] = f2bf(v0 * v0); a[o + 32] = f2bf(v1 * v1);
    }
  };
  const int ng = 64 * 32;
  const int ncv = (l < 3) ? conv_mix_count(l + 1) : 0;
  for (int it = blockIdx.x; it < ng + ncv; it += gridDim.x) {
    if (it < ng) { const int i9 = it & 511; const int nt = ((it >> 9) << 3) | ((i9 >> 3) & 7), mt = ((i9 >> 6) << 3) | (i9 & 7); gemm_tile_big<true>(smem, xb, 1024, W1t, 1024, mt * 256, nt * 128, 1.f / 1024.f, epi); }
    else conv_mix_item(p, smem, l + 1, it - ng);
  }
}

DI void run_phase(const Params& p, int ph, char* smem) {
#ifndef PHM
#define PHM 0xffff
#endif
  if (ph == 0) { if (PHM & 1) phase_prologue(p, smem); return; }
  if (ph == NPHASE - 1) { if (PHM & 2) phase_final(p); return; }
  const int l = (ph - 1) / 6, sub = (ph - 1) - l * 6;
  const bool odd = l & 1;
  char* R = p.ws + OFF_R;
  const float* xcur = (l == 0) ? p.in[0] : nullptr;
  switch (sub) {
    case 0: if (odd) { if (PHM & 4) phase_O1(p, smem, l); } else { if (PHM & 8) phase_E1(p, smem, l); } break;
    case 1:
      if (odd) { if (PHM & 16) for (int it0 = blockIdx.x; it0 < 896; it0 += gridDim.x) topk_item(p, smem, (it0 < 512) ? it0 : (1407 - it0)); }
      else { if (PHM & 32) phase_E2(p, smem, l); }
      break;
    case 2: if (odd) { if (PHM & 64) phase_O3(p, smem); } else { if (PHM & 128) phase_E3(p, smem); } break;
    case 3:
      if (!(PHM & 512)) break;
      if (odd) phase_resid_gemm(p, smem, (const bf16_t*)(R + 70 * MiB), 1024, (const bf16_t*)(R + 70 * MiB), 1024, 1 << 30,
                                (const bf16_t*)(p.ws + OFF_WMIX + 4 * MiB + 512 * 1024), 1024, xcur, false);
      else phase_resid_gemm(p, smem, (const bf16_t*)(R + 100 * MiB), 512, (const bf16_t*)R, 512, 512,
                            (const bf16_t*)(p.ws + OFF_WMIX + 4 * MiB), 1024, xcur, false);
      break;
    case 4: if (PHM & 256) phase_M1(p, smem, l); break;
    case 5: phase_resid_gemm(p, smem, (const bf16_t*)R, 4096, (const bf16_t*)R, 4096, 1 << 30, (const bf16_t*)(p.ws + OFF_WMLP + 8 * MiB), 4096,
                             nullptr, l == 3); break;
  }
}


#define XB_TMO      128
#define XB_XCNT(j)  (256  + 64 * (j))
#define XB_XSUB(j)  (1280 + 64 * (j))
#define XB_XGEN(j)  (2304 + 64 * (j))
#define XB_TOP      3328
#define XB_TOPGEN   3392
#define XCD_BAR_WORDS 3456
#define XB_SPIN_CAP (1u << 22)
#define LAS __attribute__((address_space(3)))
DI unsigned xb_ld(unsigned* p)              { return __hip_atomic_load(p, __ATOMIC_RELAXED, __HIP_MEMORY_SCOPE_AGENT); }
DI unsigned xb_add(unsigned* p, unsigned v) { return __hip_atomic_fetch_add(p, v, __ATOMIC_RELAXED, __HIP_MEMORY_SCOPE_AGENT); }
DI unsigned xb_xcc_id() { return (unsigned)__builtin_amdgcn_s_getreg((3 << 11) | 20) & 0xFu; }
#define XB_SPIN(cond, bar) do { unsigned _sp = 0; while (cond) { __builtin_amdgcn_s_sleep(1); \
    if ((++_sp & 255u) == 0u) { if (xb_ld(&(bar)[XB_TMO])) break; if (_sp > XB_SPIN_CAP) { atomicAdd(&(bar)[XB_TMO], 1u); break; } } } } while (0)
struct XcdBarrier { unsigned* bar; unsigned x; volatile LAS unsigned* st; };
DI XcdBarrier xcd_barrier_post(unsigned* bar, volatile LAS unsigned* st) {
  XcdBarrier b; b.bar = bar; b.x = xb_xcc_id(); b.st = st;
  if (__builtin_amdgcn_workitem_id_x() == 0) (void)xb_add(&bar[XB_XCNT(b.x)], 1u);
  return b;
}
DI void xcd_barrier_complete(unsigned* bar, unsigned x, unsigned& nloc, unsigned& nx) {
  const unsigned G = gridDim.x * gridDim.y * gridDim.z;
  unsigned sum, cnt, mine, sp = 0u;
  for (;;) {
    sum = 0u; cnt = 0u; mine = 0u;
#pragma unroll
    for (unsigned j = 0; j < 16; ++j) { const unsigned c = xb_ld(&bar[XB_XCNT(j)]); sum += c; cnt += (c > 0u) ? 1u : 0u; mine = (j == x) ? c : mine; }
    if (sum == G) break;
    __builtin_amdgcn_s_sleep(1);
    if ((++sp & 255u) == 0u) { if (xb_ld(&bar[XB_TMO])) break; if (sp > XB_SPIN_CAP) { atomicAdd(&bar[XB_TMO], 1u); break; } }
  }
  nloc = mine > 0u ? mine : 1u; nx = cnt > 0u ? cnt : 1u;
}
DI void xcd_barrier(const XcdBarrier& b) {
  asm volatile("s_waitcnt vmcnt(0)" ::: "memory");
  __syncthreads();
  if (__builtin_amdgcn_workitem_id_x() == 0) {
    unsigned* bar = b.bar;
    __builtin_amdgcn_s_waitcnt(0);
    unsigned nloc = b.st[0], nx = b.st[1];
    if (nloc == 0u) { xcd_barrier_complete(bar, b.x, nloc, nx); b.st[0] = nloc; b.st[1] = nx; }
    const unsigned old = xb_add(&bar[XB_XSUB(b.x)], 1u);
    const unsigned gen = old / nloc;
    if (old + 1u == (gen + 1u) * nloc) {
      __builtin_amdgcn_fence(__ATOMIC_RELEASE, "agent");
      asm volatile("s_waitcnt vmcnt(0)" ::: "memory");
      const unsigned og = xb_add(&bar[XB_TOP], 1u);
      const unsigned tg = og / nx;
      if (og + 1u == (tg + 1u) * nx) xb_add(&bar[XB_TOPGEN], 1u);
      else XB_SPIN(xb_ld(&bar[XB_TOPGEN]) == tg, bar);
      __builtin_amdgcn_fence(__ATOMIC_ACQUIRE, "agent");
      xb_add(&bar[XB_XGEN(b.x)], 1u);
      asm volatile("s_waitcnt vmcnt(0)" ::: "memory");
    } else {
      XB_SPIN(xb_ld(&bar[XB_XGEN(b.x)]) == gen, bar);
      __builtin_amdgcn_fence(__ATOMIC_ACQUIRE, "agent");
      asm volatile("s_waitcnt vmcnt(0)" ::: "memory");
    }
  }
  __syncthreads();
}
constexpr size_t OFF_BAR = OFF_MISC + 4 * MiB;

__global__ void __launch_bounds__(256, 2) mega_kernel(Params p) {
  __shared__ __attribute__((aligned(16))) char smem[SMEM_BYTES];
  cg::grid_group grid = cg::this_grid();
  if (__builtin_amdgcn_workitem_id_x() == 0) *(uint4*)(smem + SMEM_BYTES - 16) = make_uint4(0u, 0u, 0u, 0u);
  __syncthreads();
  XcdBarrier xb = xcd_barrier_post((unsigned*)(p.ws + OFF_BAR), (volatile LAS unsigned*)(smem + SMEM_BYTES - 16));
  for (int ph = p.phase_lo; ph < p.phase_hi; ++ph) {
    if (ph > p.phase_lo) {
      if (p.pad0 != 0) grid.sync();
      xcd_barrier(xb);
    }
    run_phase(p, ph, smem);
#ifdef PROBE_SUB
    if (ph > 0 && ph < NPHASE - 1 && ((ph - 1) % 6) == PROBE_SUB && ((((ph - 1) / 6) & 1) == PROBE_ODD)) { xcd_barrier(xb); run_phase(p, ph, smem); }
#endif
  }
}

extern "C" void kernel_launch(void* const* d_in, const int* in_sizes, int n_in, void* d_out, int out_size, void* d_ws, size_t ws_size,
                              hipStream_t stream) {
  Params p;
  memset(&p, 0, sizeof(p));
  for (int i = 0; i < 24; ++i) p.in[i] = (const float*)d_in[i];
  p.pos = (const int*)d_in[1];
  p.out = (float*)d_out;
  p.ws = (char*)d_ws;
  static int grid_blocks = 0;
  if (!grid_blocks) {
    int dev = 0, cus = 0, per_cu = 0;
    hipGetDevice(&dev);
    hipDeviceGetAttribute(&cus, hipDeviceAttributeMultiprocessorCount, dev);
    hipOccupancyMaxActiveBlocksPerMultiprocessor(&per_cu, mega_kernel, 256, 0);
    if (per_cu > 2) per_cu = 2;
    if (per_cu < 1) per_cu = 1;
    grid_blocks = cus * per_cu;
  }
  (void)hipMemsetAsync((char*)d_ws + OFF_BAR, 0, XCD_BAR_WORDS * sizeof(unsigned), stream);
#if MULTI_LAUNCH
  for (int ph = 0; ph < NPHASE; ++ph) {
    p.phase_lo = ph; p.phase_hi = ph + 1;
    hipLaunchKernelGGL(mega_kernel, dim3(grid_blocks), dim3(256), 0, stream, p);
  }
#else
  p.phase_lo = 0; p.phase_hi = NPHASE;
  void* args[] = {&p};
  hipError_t e = hipLaunchCooperativeKernel((void*)mega_kernel, dim3(grid_blocks), dim3(256), args, 0, stream);
  if (e != hipSuccess) fprintf(stderr, "cooperative launch failed: %s (grid %d)\n", hipGetErrorString(e), grid_blocks);
#endif
}
```

```cpp
#include <hip/hip_runtime.h>
#include <hip/hip_cooperative_groups.h>
#include <stdint.h>
#include <string.h>
#include <stdio.h>
namespace cg = cooperative_groups;

#ifndef MULTI_LAUNCH
#define MULTI_LAUNCH 0
#endif

typedef __attribute__((ext_vector_type(8))) short bf16x8;
typedef __attribute__((ext_vector_type(16))) float f32x16;
typedef __attribute__((ext_vector_type(4))) float f32x4;
typedef unsigned short bf16_t;

#define DI __device__ __forceinline__
#define MFMA32(a, b, c) __builtin_amdgcn_mfma_f32_32x32x16_bf16((a), (b), (c), 0, 0, 0)
#define MFMA16(a, b, c) __builtin_amdgcn_mfma_f32_16x16x32_bf16((a), (b), (c), 0, 0, 0)
#define CROW(i, h) (((i) & 3) + 8 * ((i) >> 2) + 4 * (h))

constexpr int S = 2048, T = 16384;
constexpr float EPSV = 1e-6f;
constexpr float LOG2E = 1.4426950408889634f;
constexpr int NPHASE = 26;
constexpr int SMEM_BYTES = 66688;

constexpr size_t MiB = 1ull << 20;
constexpr size_t OFF_X = 0, OFF_XB = 64 * MiB, OFF_WMLP = 96 * MiB, OFF_WMIX = 112 * MiB, OFF_MISC = 119 * MiB, OFF_R = 124 * MiB;

struct Params {
  const float* in[24];
  const int* pos;
  float* out;
  char* ws;
  int phase_lo, phase_hi;
  int pad0, pad1;
};

DI int TIDX() { int t = __builtin_amdgcn_workitem_id_x(); asm volatile("" : "+v"(t)); return t; }
typedef __attribute__((ext_vector_type(2))) __bf16 bf2v_t;
typedef __attribute__((ext_vector_type(2))) float f2v_t;
DI bf16_t f2bf(float x) { __bf16 r = (__bf16)x; return __builtin_bit_cast(bf16_t, r); }
DI float bf2f(bf16_t b) { return __uint_as_float(((unsigned)b) << 16); }
DI unsigned pack2(float a, float b) { f2v_t v = {a, b}; bf2v_t r = __builtin_convertvector(v, bf2v_t); return __builtin_bit_cast(unsigned, r); }
DI float lo2f(unsigned v) { return __uint_as_float(v << 16); }
DI float hi2f(unsigned v) { return __uint_as_float(v & 0xffff0000u); }
DI f32x16 zero16() { f32x16 z;
#pragma unroll
  for (int i = 0; i < 16; ++i) z[i] = 0.f; return z; }
DI float sigmoidf_(float x) { return 1.f / (1.f + __expf(-x)); }
DI float gelu_tanh(float x) { float y = 0.7978845608028654f * (x + 0.044715f * x * x * x); float t = 1.f - 2.f / (__expf(2.f * y) + 1.f); return 0.5f * x * (1.f + t); }
DI float sumsq8(const uint4& v) {
  float s = 0.f;
  s += lo2f(v.x) * lo2f(v.x); s += hi2f(v.x) * hi2f(v.x);
  s += lo2f(v.y) * lo2f(v.y); s += hi2f(v.y) * hi2f(v.y);
  s += lo2f(v.z) * lo2f(v.z); s += hi2f(v.z) * hi2f(v.z);
  s += lo2f(v.w) * lo2f(v.w); s += hi2f(v.w) * hi2f(v.w);
  return s;
}

typedef __attribute__((ext_vector_type(2))) __bf16 bf2_t;
DI float sumsq_frag(const bf16x8& f, float acc) {
  const uint4 u = __builtin_bit_cast(uint4, f);
  acc = __builtin_amdgcn_fdot2_f32_bf16(__builtin_bit_cast(bf2_t, u.x), __builtin_bit_cast(bf2_t, u.x), acc, false);
  acc = __builtin_amdgcn_fdot2_f32_bf16(__builtin_bit_cast(bf2_t, u.y), __builtin_bit_cast(bf2_t, u.y), acc, false);
  acc = __builtin_amdgcn_fdot2_f32_bf16(__builtin_bit_cast(bf2_t, u.z), __builtin_bit_cast(bf2_t, u.z), acc, false);
  acc = __builtin_amdgcn_fdot2_f32_bf16(__builtin_bit_cast(bf2_t, u.w), __builtin_bit_cast(bf2_t, u.w), acc, false);
  return acc;
}

template <bool NORM, class Epi>
DI void gemm_tile(char* smem, const bf16_t* a0, int lda0, const bf16_t* a1, int lda1, int ksplit,
                  const bf16_t* Wt, int K, int m0, int n0, float inv_nk, Epi epi) {
  __syncthreads();
  float* rs = (float*)(smem + 65536);
  const int tid = TIDX(), lane = tid & 63, w = tid >> 6, r = lane & 31, h = lane >> 5, wm = w >> 1, wn = w & 1;
  const int nkt = K >> 6;
  const int grow = w * 8 + (lane >> 3);
  const int gch = ((lane & 7) ^ ((4 * (w & 1) + (lane >> 4)) & 7)) * 8;
  const bf16_t* bsrc = Wt + (size_t)(n0 + grow) * K + gch;
  const size_t bstep = (size_t)32 * K;
  auto glds = [&](int kt, int buf) __attribute__((always_inline)) {
    const int k = kt * 64;
    const bf16_t* ab; int lda;
    if (k < ksplit) { ab = a0 + k; lda = lda0; } else { ab = a1 + (k - ksplit); lda = lda1; }
    const bf16_t* asrc = ab + (size_t)(m0 + grow) * lda + gch;
    const size_t astep = (size_t)32 * lda;
    char* lb = smem + buf * 32768 + w * 1024;
    __builtin_amdgcn_global_load_lds((const unsigned*)(asrc), (__attribute__((address_space(3))) unsigned*)(lb), 16, 0, 0);
    __builtin_amdgcn_global_load_lds((const unsigned*)(asrc + astep), (__attribute__((address_space(3))) unsigned*)(lb + 4096), 16, 0, 0);
    __builtin_amdgcn_global_load_lds((const unsigned*)(asrc + 2 * astep), (__attribute__((address_space(3))) unsigned*)(lb + 8192), 16, 0, 0);
    __builtin_amdgcn_global_load_lds((const unsigned*)(asrc + 3 * astep), (__attribute__((address_space(3))) unsigned*)(lb + 12288), 16, 0, 0);
    __builtin_amdgcn_global_load_lds((const unsigned*)(bsrc + k), (__attribute__((address_space(3))) unsigned*)(lb + 16384), 16, 0, 0);
    __builtin_amdgcn_global_load_lds((const unsigned*)(bsrc + k + bstep), (__attribute__((address_space(3))) unsigned*)(lb + 16384 + 4096), 16, 0, 0);
    __builtin_amdgcn_global_load_lds((const unsigned*)(bsrc + k + 2 * bstep), (__attribute__((address_space(3))) unsigned*)(lb + 16384 + 8192), 16, 0, 0);
    __builtin_amdgcn_global_load_lds((const unsigned*)(bsrc + k + 3 * bstep), (__attribute__((address_space(3))) unsigned*)(lb + 16384 + 12288), 16, 0, 0);
  };
  f32x16 acc00 = zero16(), acc01 = zero16(), acc10 = zero16(), acc11 = zero16();
  float ss0 = 0.f, ss1 = 0.f;
  const int sw = (r >> 1) & 7;
  const int aoff = (wm * 64 + r) * 128, boff = 16384 + (wn * 64 + r) * 128;
  glds(0, 0);
  for (int kt = 0; kt < nkt; ++kt) {
    asm volatile("s_waitcnt vmcnt(0)" ::: "memory");
    asm volatile("s_waitcnt lgkmcnt(0)" ::: "memory");
    __builtin_amdgcn_s_barrier();
    const char* base = smem + (kt & 1) * 32768;
    bf16x8 af0[4], af1[4], bf0[4], bf1[4];
#pragma unroll
    for (int ks = 0; ks < 4; ++ks) {
      const int p = ((2 * ks + h) ^ sw) * 16;
      af0[ks] = *(const bf16x8*)(base + aoff + p); af1[ks] = *(const bf16x8*)(base + aoff + 4096 + p);
      bf0[ks] = *(const bf16x8*)(base + boff + p); bf1[ks] = *(const bf16x8*)(base + boff + 4096 + p);
    }
    __builtin_amdgcn_sched_barrier(0);
    if (kt + 1 < nkt) glds(kt + 1, (kt + 1) & 1);
    __builtin_amdgcn_sched_barrier(0);
#pragma unroll
    for (int ks = 0; ks < 4; ++ks) {
      if (NORM) { ss0 = sumsq_frag(af0[ks], ss0); ss1 = sumsq_frag(af1[ks], ss1); }
      acc00 = MFMA32(af0[ks], bf0[ks], acc00); acc01 = MFMA32(af0[ks], bf1[ks], acc01);
      acc10 = MFMA32(af1[ks], bf0[ks], acc10); acc11 = MFMA32(af1[ks], bf1[ks], acc11);
    }
  }
  if (NORM) {
    ss0 += __shfl_xor(ss0, 32); ss1 += __shfl_xor(ss1, 32);
    if (wn == 0 && h == 0) { rs[wm * 64 + r] = rsqrtf(ss0 * inv_nk + EPSV); rs[wm * 64 + 32 + r] = rsqrtf(ss1 * inv_nk + EPSV); }
    __syncthreads();
  }
  epi(m0 + wm * 64, n0 + wn * 64, acc00, acc01, rs + wm * 64);
  epi(m0 + wm * 64 + 32, n0 + wn * 64, acc10, acc11, rs + wm * 64 + 32);
}

template <bool NORM, class Epi>
DI void gemm_tile_big(char* smem, const bf16_t* A, int lda, const bf16_t* Wt, int K, int m0, int n0, float inv_nk, Epi epi,
                       const bf16_t* A2 = nullptr, int ksplit = 1 << 30) {
  __syncthreads();
  float* rs = (float*)(smem + 65536);
  const int tid = TIDX(), lane = tid & 63, w = tid >> 6, r = lane & 31, h = lane >> 5, wm = w >> 1, wn = w & 1;
  const int nkt = K >> 5;
  const int wu = __builtin_amdgcn_readfirstlane(w);
  const int grow = wu * 16 + (lane >> 2);
  const int gch = ((lane & 3) ^ ((lane >> 4) & 3)) * 8;
  const unsigned aoffl = (unsigned)(grow * lda + gch) * 2u;
  const unsigned boffl = (unsigned)(grow * K + gch) * 2u;
  const char* abase = (const char*)(A + (size_t)m0 * lda);
  const char* abase2 = A2 ? (const char*)(A2 + (size_t)m0 * lda) - (size_t)ksplit * 2 : abase;
  const char* bbase = (const char*)(Wt + (size_t)n0 * K);
  const size_t astep = (size_t)64 * lda * 2, bstep = (size_t)64 * K * 2;
  auto glds = [&](int kt, int buf) __attribute__((always_inline)) {
    const size_t kb = (size_t)kt * 64;
    char* lb = smem + buf * 24576 + wu * 1024;
    const char* u0 = ((kt * 32 < ksplit) ? abase : abase2) + kb; const char* u1 = u0 + astep; const char* u2 = u1 + astep; const char* u3 = u2 + astep;
    const char* v0 = bbase + kb; const char* v1 = v0 + bstep;
    asm volatile("" : "+s"(u0), "+s"(u1), "+s"(u2), "+s"(u3), "+s"(v0), "+s"(v1));
    __builtin_amdgcn_global_load_lds((const unsigned*)(u0 + (size_t)aoffl), (__attribute__((address_space(3))) unsigned*)(lb), 16, 0, 0);
    __builtin_amdgcn_global_load_lds((const unsigned*)(u1 + (size_t)aoffl), (__attribute__((address_space(3))) unsigned*)(lb + 4096), 16, 0, 0);
    __builtin_amdgcn_global_load_lds((const unsigned*)(u2 + (size_t)aoffl), (__attribute__((address_space(3))) unsigned*)(lb + 8192), 16, 0, 0);
    __builtin_amdgcn_global_load_lds((const unsigned*)(u3 + (size_t)aoffl), (__attribute__((address_space(3))) unsigned*)(lb + 12288), 16, 0, 0);
    __builtin_amdgcn_global_load_lds((const unsigned*)(v0 + (size_t)boffl), (__attribute__((address_space(3))) unsigned*)(lb + 16384), 16, 0, 0);
    __builtin_amdgcn_global_load_lds((const unsigned*)(v1 + (size_t)boffl), (__attribute__((address_space(3))) unsigned*)(lb + 16384 + 4096), 16, 0, 0);
  };
  f32x16 acc[4][2];
#pragma unroll
  for (int mt = 0; mt < 4; ++mt) { acc[mt][0] = zero16(); acc[mt][1] = zero16(); }
  float ss[4] = {0.f, 0.f, 0.f, 0.f};
  const int sw = (r >> 2) & 3;
  const int aoff = (wm * 128 + r) * 64, boff = 16384 + (wn * 64 + r) * 64;
  const int p0 = ((0 + h) ^ sw) * 16, p1 = ((2 + h) ^ sw) * 16;
  __builtin_amdgcn_s_waitcnt(0x0F70);
  glds(0, 0);
  for (int kt = 0; kt < nkt; ++kt) {
    __builtin_amdgcn_s_waitcnt(0x0070);
    __builtin_amdgcn_s_barrier();
    const char* base = smem + (kt & 1) * 24576;
    bf16x8 af[4][2], bf[2][2];
#pragma unroll
    for (int mt = 0; mt < 4; ++mt) { af[mt][0] = *(const bf16x8*)(base + aoff + mt * 2048 + p0); af[mt][1] = *(const bf16x8*)(base + aoff + mt * 2048 + p1); }
#pragma unroll
    for (int nt = 0; nt < 2; ++nt) { bf[nt][0] = *(const bf16x8*)(base + boff + nt * 2048 + p0); bf[nt][1] = *(const bf16x8*)(base + boff + nt * 2048 + p1); }
    __builtin_amdgcn_sched_barrier(0);
    if (kt + 1 < nkt) glds(kt + 1, (kt + 1) & 1);
    __builtin_amdgcn_sched_barrier(0);
#pragma unroll
    for (int ks = 0; ks < 2; ++ks)
#pragma unroll
      for (int mt = 0; mt < 4; ++mt) {
        if (NORM) ss[mt] = sumsq_frag(af[mt][ks], ss[mt]);
        acc[mt][0] = MFMA32(af[mt][ks], bf[0][ks], acc[mt][0]);
        acc[mt][1] = MFMA32(af[mt][ks], bf[1][ks], acc[mt][1]);
      }
  }
  if (NORM) {
#pragma unroll
    for (int mt = 0; mt < 4; ++mt) {
      ss[mt] += __shfl_xor(ss[mt], 32);
      if (wn == 0 && h == 0) rs[wm * 128 + mt * 32 + r] = rsqrtf(ss[mt] * inv_nk + EPSV);
    }
    __syncthreads();
  }
#pragma unroll
  for (int mt = 0; mt < 4; ++mt) epi(m0 + wm * 128 + mt * 32, n0 + wn * 64, acc[mt][0], acc[mt][1], rs + wm * 128 + mt * 32);
}

DI void conv_tile(char* smem, const float* __restrict__ src, int K, int N, const float* __restrict__ gain, bf16_t* __restrict__ dst, int tile, int ntn) {
  __syncthreads();
  const int tid = TIDX();
  const int kt = tile / ntn, nt = tile - kt * ntn, k0 = kt * 64, n0 = nt * 64;
  float* t = (float*)smem;
  float cv[16];
#pragma unroll
  for (int it = 0; it < 16; ++it) {
    const int e = tid + 256 * it, kk = e >> 6, nn = e & 63, n = n0 + nn;
    cv[it] = (n < N) ? __builtin_nontemporal_load(&src[(size_t)(k0 + kk) * N + n]) : 0.f;
  }
  float gv[16];
  if (gain) {
#pragma unroll
    for (int it = 0; it < 16; ++it) gv[it] = gain[k0 + ((tid + 256 * it) >> 6)];
  } else {
#pragma unroll
    for (int it = 0; it < 16; ++it) gv[it] = 1.f;
  }
#pragma unroll
  for (int it = 0; it < 16; ++it) {
    const int e = tid + 256 * it, kk = e >> 6, nn = e & 63;
    t[kk * 65 + nn] = cv[it] * gv[it];
  }
  __syncthreads();
#pragma unroll
  for (int it = 0; it < 2; ++it) {
    const int e = tid + 256 * it, nn = e >> 3, ko = (e & 7) * 8;
    uint4 o;
    o.x = pack2(t[(ko + 0) * 65 + nn], t[(ko + 1) * 65 + nn]);
    o.y = pack2(t[(ko + 2) * 65 + nn], t[(ko + 3) * 65 + nn]);
    o.z = pack2(t[(ko + 4) * 65 + nn], t[(ko + 5) * 65 + nn]);
    o.w = pack2(t[(ko + 6) * 65 + nn], t[(ko + 7) * 65 + nn]);
    *(uint4*)(dst + (size_t)(n0 + nn) * K + k0 + ko) = o;
  }
}

constexpr int CONV_MLP_ITEMS = 2048;
DI void conv_mlp_item(const Params& p, char* smem, int l, int item) {
  bf16_t* w1t = (bf16_t*)(p.ws + OFF_WMLP);
  bf16_t* w2t = (bf16_t*)(p.ws + OFF_WMLP + 8 * MiB);
  if (item < 1024) conv_tile(smem, p.in[21] + (size_t)l * 1024 * 4096, 1024, 4096, p.in[20] + l * 1024, w1t, item, 64);
  else conv_tile(smem, p.in[22] + (size_t)l * 4096 * 1024, 4096, 1024, nullptr, w2t, item - 1024, 16);
}
DI int conv_mix_count(int l) { return (l & 1) ? 800 : 736; }
DI void conv_mix_item(const Params& p, char* smem, int l, int item) {
  const int j = l >> 1;
  char* wm = p.ws + OFF_WMIX;
  if (l & 1) {
    if (item < 544) conv_tile(smem, p.in[17] + (size_t)j * 1024 * 2120, 1024, 2120, p.in[16] + j * 1024, (bf16_t*)wm, item, 34);
    else conv_tile(smem, p.in[19] + (size_t)j * 1024 * 1024, 1024, 1024, nullptr, (bf16_t*)(wm + 4 * MiB + 512 * 1024), item - 544, 16);
  } else {
    if (item < 384) conv_tile(smem, p.in[3] + (size_t)j * 1024 * 1440, 1024, 1440, p.in[2] + j * 1024, (bf16_t*)wm, item, 24);
    else if (item < 432) conv_tile(smem, p.in[12] + (size_t)j * 256 * 768, 256, 768, p.in[11] + j * 256, (bf16_t*)(wm + 3 * MiB), item - 384, 12);
    else if (item < 464) conv_tile(smem, p.in[14] + (size_t)j * 128 * 1024, 128, 1024, p.in[13] + j * 128, (bf16_t*)(wm + 3 * MiB + 512 * 1024), item - 432, 16);
    else if (item < 720) conv_tile(smem, p.in[15] + (size_t)j * 1024 * 1024, 1024, 1024, nullptr, (bf16_t*)(wm + 4 * MiB), item - 464, 16);
    else if (item < 728) { const int n = item - 720; conv_tile(smem, p.in[6] + ((size_t)j * 8 + n) * 4096, 64, 64, nullptr, (bf16_t*)(wm + 6 * MiB) + n * 4096, 0, 1); }
    else { const int n = item - 728; conv_tile(smem, p.in[8] + ((size_t)j * 8 + n) * 4096, 64, 64, nullptr, (bf16_t*)(wm + 6 * MiB + 65536) + n * 4096, 0, 1); }
  }
}

template <int DQK>
struct QTile { bf16x8 qf[DQK / 16]; f32x16 o0, o1; float m, l; };

template <int DQK>
DI void attn_qt_init(QTile<DQK>& q, const bf16_t* __restrict__ Qrow, int h) {
#pragma unroll
  for (int ks = 0; ks < DQK / 16; ++ks) q.qf[ks] = *(const bf16x8*)(Qrow + ks * 16 + h * 8);
  q.o0 = zero16(); q.o1 = zero16(); q.m = -1e30f; q.l = 0.f;
}

template <int DQK, bool MASK>
DI void attn_qt_step(QTile<DQK>& q, const bf16_t* Ks, const bf16_t* Vs, unsigned mw0, unsigned mw1, int r, int h) {
  constexpr int KST = DQK + 8;
  constexpr int NKS = DQK / 16;
  f32x16 st0 = zero16(), st1 = zero16();
#pragma unroll
  for (int ks = 0; ks < NKS; ++ks) {
    const bf16x8 a0 = *(const bf16x8*)(Ks + r * KST + ks * 16 + h * 8);
    const bf16x8 a1 = *(const bf16x8*)(Ks + (32 + r) * KST + ks * 16 + h * 8);
    st0 = MFMA32(a0, q.qf[ks], st0);
    st1 = MFMA32(a1, q.qf[ks], st1);
  }
  float mx = -1e30f;
#pragma unroll
  for (int i = 0; i < 16; ++i) {
    const int cr = CROW(i, h);
    if (!MASK || ((mw0 >> cr) & 1u)) mx = fmaxf(mx, st0[i]);
    if (!MASK || ((mw1 >> cr) & 1u)) mx = fmaxf(mx, st1[i]);
  }
  mx = fmaxf(mx, __shfl_xor(mx, 32));
  const float mnew = fmaxf(q.m, mx);
  const float alpha = __builtin_amdgcn_exp2f(q.m - mnew);
  q.m = mnew;
  float ps = 0.f;
#pragma unroll
  for (int i = 0; i < 16; ++i) {
    const int cr = CROW(i, h);
    const float p0 = (!MASK || ((mw0 >> cr) & 1u)) ? __builtin_amdgcn_exp2f(st0[i] - mnew) : 0.f;
    const float p1 = (!MASK || ((mw1 >> cr) & 1u)) ? __builtin_amdgcn_exp2f(st1[i] - mnew) : 0.f;
    st0[i] = p0; st1[i] = p1; ps += p0 + p1;
  }
  q.l = q.l * alpha + ps;
#pragma unroll
  for (int i = 0; i < 16; ++i) { q.o0[i] *= alpha; q.o1[i] *= alpha; }
#pragma unroll
  for (int s2 = 0; s2 < 2; ++s2) {
    uint4 pk0, pk1;
    pk0.x = pack2(st0[8 * s2 + 0], st0[8 * s2 + 1]); pk0.y = pack2(st0[8 * s2 + 2], st0[8 * s2 + 3]);
    pk0.z = pack2(st0[8 * s2 + 4], st0[8 * s2 + 5]); pk0.w = pack2(st0[8 * s2 + 6], st0[8 * s2 + 7]);
    pk1.x = pack2(st1[8 * s2 + 0], st1[8 * s2 + 1]); pk1.y = pack2(st1[8 * s2 + 2], st1[8 * s2 + 3]);
    pk1.z = pack2(st1[8 * s2 + 4], st1[8 * s2 + 5]); pk1.w = pack2(st1[8 * s2 + 6], st1[8 * s2 + 7]);
    const bf16x8 pf0 = __builtin_bit_cast(bf16x8, pk0), pf1 = __builtin_bit_cast(bf16x8, pk1);
    {
      const bf16_t* vp = Vs + r * 68 + 16 * s2 + 4 * h;
      const uint2 lo = *(const uint2*)vp, hi = *(const uint2*)(vp + 8);
      const uint2 lo2 = *(const uint2*)(vp + 32 * 68), hi2 = *(const uint2*)(vp + 32 * 68 + 8);
      q.o0 = MFMA32(__builtin_bit_cast(bf16x8, make_uint4(lo.x, lo.y, hi.x, hi.y)), pf0, q.o0);
      q.o1 = MFMA32(__builtin_bit_cast(bf16x8, make_uint4(lo2.x, lo2.y, hi2.x, hi2.y)), pf0, q.o1);
    }
    {
      const bf16_t* vp = Vs + r * 68 + 32 + 16 * s2 + 4 * h;
      const uint2 lo = *(const uint2*)vp, hi = *(const uint2*)(vp + 8);
      const uint2 lo2 = *(const uint2*)(vp + 32 * 68), hi2 = *(const uint2*)(vp + 32 * 68 + 8);
      q.o0 = MFMA32(__builtin_bit_cast(bf16x8, make_uint4(lo.x, lo.y, hi.x, hi.y)), pf1, q.o0);
      q.o1 = MFMA32(__builtin_bit_cast(bf16x8, make_uint4(lo2.x, lo2.y, hi2.x, hi2.y)), pf1, q.o1);
    }
  }
}

template <int DQK>
DI void attn_qt_store(QTile<DQK>& q, bf16_t* __restrict__ orow, int h) {
  const float lt = q.l + __shfl_xor(q.l, 32);
  const float inv = 1.f / lt;
#pragma unroll
  for (int g4 = 0; g4 < 4; ++g4) {
    const int d0 = 8 * g4 + 4 * h;
    uint2 v;
    v.x = pack2(q.o0[4 * g4 + 0] * inv, q.o0[4 * g4 + 1] * inv); v.y = pack2(q.o0[4 * g4 + 2] * inv, q.o0[4 * g4 + 3] * inv);
    *(uint2*)(orow + d0) = v;
    v.x = pack2(q.o1[4 * g4 + 0] * inv, q.o1[4 * g4 + 1] * inv); v.y = pack2(q.o1[4 * g4 + 2] * inv, q.o1[4 * g4 + 3] * inv);
    *(uint2*)(orow + 32 + d0) = v;
  }
}

template <int DQK, int NQT, bool MASK>
DI void attn_core(char* smem, const bf16_t* __restrict__ Kg, const bf16_t* __restrict__ Vtg, const bf16_t* __restrict__ Qw,
                  int nch_blk, int nch_wave, bf16_t* __restrict__ outp, int ostride) {
  constexpr int KST = DQK + 8;
  constexpr int C8 = DQK / 8;
  bf16_t* Ks = (bf16_t*)smem;
  bf16_t* Vs = (bf16_t*)(smem + 13312);
  const unsigned* maskl = (const unsigned*)(smem + 22016);
  const int tid = TIDX(), lane = tid & 63, r = lane & 31, h = lane >> 5;
  QTile<DQK> q0, q1;
  attn_qt_init<DQK>(q0, Qw + (size_t)r * DQK, h);
  if (NQT > 1) attn_qt_init<DQK>(q1, Qw + (size_t)(32 + r) * DQK, h);
  uint4 kr0, kr1, kr2, vr0, vr1;
  const int vd0 = tid >> 3, vc8 = tid & 7;
#define ATTN_GLOAD(kc_)                                                                          \
  {                                                                                              \
    const uint4* kp_ = (const uint4*)(Kg + (size_t)(kc_) * 64 * DQK);                            \
    kr0 = kp_[tid]; kr1 = kp_[tid + 256];                                                        \
    if (DQK == 96) kr2 = kp_[tid + 512];                                                         \
    vr0 = *(const uint4*)(Vtg + (size_t)vd0 * S + (kc_) * 64 + vc8 * 8);                         \
    vr1 = *(const uint4*)(Vtg + (size_t)(vd0 + 32) * S + (kc_) * 64 + vc8 * 8);                  \
  }
  ATTN_GLOAD(0);
  for (int kc = 0; kc < nch_blk; ++kc) {
    __syncthreads();
    {
      { const int e = tid, row = e / C8, c8 = e - row * C8; *(uint4*)(Ks + row * KST + c8 * 8) = kr0; }
      { const int e = tid + 256, row = e / C8, c8 = e - row * C8; *(uint4*)(Ks + row * KST + c8 * 8) = kr1; }
      if (DQK == 96) { const int e = tid + 512, row = e / C8, c8 = e - row * C8; *(uint4*)(Ks + row * KST + c8 * 8) = kr2; }
      uint2* vp = (uint2*)(Vs + vd0 * 68 + vc8 * 8);
      vp[0] = make_uint2(vr0.x, vr0.y); vp[1] = make_uint2(vr0.z, vr0.w);
      vp = (uint2*)(Vs + (vd0 + 32) * 68 + vc8 * 8);
      vp[0] = make_uint2(vr1.x, vr1.y); vp[1] = make_uint2(vr1.z, vr1.w);
    }
    __syncthreads();
    if (kc + 1 < nch_blk) ATTN_GLOAD(kc + 1);
    if (kc < nch_wave) {
      unsigned mw0 = 0xffffffffu, mw1 = 0xffffffffu;
      if (MASK) { mw0 = maskl[r * 65 + 2 * kc]; mw1 = maskl[r * 65 + 2 * kc + 1]; }
      attn_qt_step<DQK, MASK>(q0, Ks, Vs, mw0, mw1, r, h);
      if (NQT > 1) {
        __builtin_amdgcn_sched_barrier(0);
        mw0 = 0xffffffffu; mw1 = 0xffffffffu;
        if (MASK) { mw0 = maskl[(32 + r) * 65 + 2 * kc]; mw1 = maskl[(32 + r) * 65 + 2 * kc + 1]; }
        attn_qt_step<DQK, MASK>(q1, Ks, Vs, mw0, mw1, r, h);
      }
    }
  }
#undef ATTN_GLOAD
  attn_qt_store<DQK>(q0, outp + (size_t)r * ostride, h);
  if (NQT > 1) attn_qt_store<DQK>(q1, outp + (size_t)(32 + r) * ostride, h);
}

DI void lru1_item(const Params& p, char* smem, int j, int item) {
  __syncthreads();
  const int n = item & 7, ch = (item >> 3) & 31, b = item >> 8;
  const int t0 = b * S + ch * 64, c0 = n * 64;
  char* R = p.ws + OFF_R;
  const bf16_t* xr = (const bf16_t*)(R);
  bf16_t* Pg = (bf16_t*)(R + 84 * MiB);
  bf16_t* hl = (bf16_t*)(R + 100 * MiB);
  float* Asum = (float*)(p.ws + OFF_MISC + 2 * MiB);
  float* Bsum = (float*)(p.ws + OFF_MISC + 2 * MiB + 512 * 1024);
  const bf16_t* gaT = (const bf16_t*)(p.ws + OFF_WMIX + 6 * MiB) + n * 4096;
  const bf16_t* gxT = (const bf16_t*)(p.ws + OFF_WMIX + 6 * MiB + 65536) + n * 4096;
  const float* conv_w = p.in[4] + j * 4 * 512;
  const float* conv_b = p.in[5] + j * 512;
  const float* ga_b = p.in[7] + j * 512;
  const float* gx_b = p.in[9] + j * 512;
  const float* lam = p.in[10] + j * 512;
  bf16_t* xcb = (bf16_t*)smem;
  float* av = (float*)(smem + 9216);
  float* bv = (float*)(smem + 25600);
  const int tid = TIDX(), lane = tid & 63, w = tid >> 6, r = lane & 31, h = lane >> 5;
  {
    const int cp = tid & 31, c = c0 + 2 * cp, tb = tid >> 5;
    float2 wq[4];
#pragma unroll
    for (int q = 0; q < 4; ++q) wq[q] = *(const float2*)(conv_w + q * 512 + c);
    const float2 bb = *(const float2*)(conv_b + c);
    unsigned xv[8][4];
#pragma unroll
    for (int it = 0; it < 8; ++it)
#pragma unroll
      for (int q = 0; q < 4; ++q) {
        const int t = tb + 8 * it, sl = ch * 64 + t - 3 + q;
        const int row = (sl >= 0) ? (t0 + t - 3 + q) : t0;
        xv[it][q] = *(const unsigned*)(xr + (size_t)row * 512 + c);
      }
#pragma unroll
    for (int it = 0; it < 8; ++it) {
      const int t = tb + 8 * it;
      float x0 = bb.x, x1 = bb.y;
#pragma unroll
      for (int q = 0; q < 4; ++q) {
        const int sl = ch * 64 + t - 3 + q;
        const unsigned v = (sl >= 0) ? xv[it][q] : 0u;
        x0 += lo2f(v) * wq[q].x; x1 += hi2f(v) * wq[q].y;
      }
      *(float2*)(bv + t * 64 + 2 * cp) = make_float2(x0, x1);
      *(unsigned*)(xcb + t * 72 + 2 * cp) = pack2(x0, x1);
    }
  }
  const int gchan = c0 + 32 * (w & 1) + r;
  const float g_lam = lam[gchan], g_gab = ga_b[gchan], g_gxb = gx_b[gchan];
  __syncthreads();
  {
    const int mt = w >> 1, nt = w & 1;
    f32x16 ga = zero16(), gx = zero16();
#pragma unroll
    for (int ks = 0; ks < 4; ++ks) {
      const bf16x8 a = *(const bf16x8*)(xcb + (32 * mt + r) * 72 + 16 * ks + 8 * h);
      const bf16x8 ba = *(const bf16x8*)(gaT + (32 * nt + r) * 64 + 16 * ks + 8 * h);
      const bf16x8 bx = *(const bf16x8*)(gxT + (32 * nt + r) * 64 + 16 * ks + 8 * h);
      ga = MFMA32(a, ba, ga); gx = MFMA32(a, bx, gx);
    }
    const int c = 32 * nt + r, chan = c0 + c;
    const float el = __expf(-g_lam);
    const float sp = (el < 0.02f) ? el * (1.f - el * (0.5f - el * (0.33333334f - 0.25f * el))) : __logf(1.f + el);
    const float la = -8.f * sp;
    const float gab = g_gab, gxb = g_gxb;
#pragma unroll
    for (int i = 0; i < 16; ++i) {
      const int t = 32 * mt + CROW(i, h);
      const float rg = sigmoidf_(ga[i] + gab), ig = sigmoidf_(gx[i] + gxb);
      const float log_a = la * rg;
      const float a = __expf(log_a);
      const float mult = sqrtf(fmaxf(1.f - a * a, 0.f));
      const float xcv = bv[t * 64 + c];
      av[t * 64 + c] = a;
      bv[t * 64 + c] = mult * ig * xcv;
    }
  }
  __syncthreads();
  {
    const int c = tid & 63, q = tid >> 6;
    float A = 1.f, H = 0.f;
    const int tend = 16 * q + 16;
#pragma unroll 4
    for (int t = 0; t < tend; ++t) {
      const float a = av[t * 64 + c];
      H = a * H + bv[t * 64 + c];
      A *= a;
      if (t >= 16 * q) {
        hl[(size_t)(t0 + t) * 512 + c0 + c] = f2bf(H);
        Pg[(size_t)(t0 + t) * 512 + c0 + c] = f2bf(A);
      }
    }
    if (q == 3) { Asum[(b * 32 + ch) * 512 + c0 + c] = A; Bsum[(b * 32 + ch) * 512 + c0 + c] = H; }
  }
}

DI void lru2_item(const Params& p, char* smem, int item) {
  __syncthreads();
  const int ch = item & 31, b = item >> 5;
  char* R = p.ws + OFF_R;
  const bf16_t* gg = (const bf16_t*)(R + 16 * MiB);
  const bf16_t* Pg = (const bf16_t*)(R + 84 * MiB);
  bf16_t* hl = (bf16_t*)(R + 100 * MiB);
  const float* Asum = (const float*)(p.ws + OFF_MISC + 2 * MiB);
  const float* Bsum = (const float*)(p.ws + OFF_MISC + 2 * MiB + 512 * 1024);
  float* carry = (float*)smem;
  const int tid = TIDX();
#pragma unroll
  for (int k = 0; k < 2; ++k) {
    const int c = tid + 256 * k;
    float H = 0.f;
    for (int q0 = 0; q0 < ch; q0 += 8) {
      float ca[8], cb2[8];
#pragma unroll
      for (int u = 0; u < 8; ++u) { const int q = (q0 + u < 32) ? (q0 + u) : 31; ca[u] = Asum[(b * 32 + q) * 512 + c]; cb2[u] = Bsum[(b * 32 + q) * 512 + c]; }
#pragma unroll
      for (int u = 0; u < 8; ++u) { const bool on = (q0 + u) < ch; H = (on ? ca[u] : 1.f) * H + (on ? cb2[u] : 0.f); }
    }
    carry[c] = H;
  }
  __syncthreads();
  const size_t base = (size_t)(b * S + ch * 64) * 512;
#pragma unroll 1
  for (int it0 = 0; it0 < 64; it0 += 16) {
    unsigned hv[16], pv[16], gv[16];
#pragma unroll
    for (int u = 0; u < 16; ++u) {
      const int e = tid + 256 * (it0 + u);
      const size_t off = base + (size_t)(e >> 8) * 512 + 2 * (e & 255);
      hv[u] = *(const unsigned*)(hl + off); pv[u] = *(const unsigned*)(Pg + off); gv[u] = *(const unsigned*)(gg + off);
    }
#pragma unroll
    for (int u = 0; u < 16; ++u) {
      const int e = tid + 256 * (it0 + u);
      const int c = 2 * (e & 255);
      const size_t off = base + (size_t)(e >> 8) * 512 + c;
      const float y0 = (lo2f(hv[u]) + lo2f(pv[u]) * carry[c]) * lo2f(gv[u]);
      const float y1 = (hi2f(hv[u]) + hi2f(pv[u]) * carry[c + 1]) * hi2f(gv[u]);
      *(unsigned*)(hl + off) = pack2(y0, y1);
    }
  }
}

DI unsigned tokey(float f) { unsigned u = __float_as_uint(f + 0.0f); return (u & 0x80000000u) ? ~u : (u | 0x80000000u); }

DI int tk_cnt(const int* hist, int hq, int bin) {
  return hist[(0 * 16 + hq) * 256 + bin] + hist[(1 * 16 + hq) * 256 + bin] + hist[(2 * 16 + hq) * 256 + bin] + hist[(3 * 16 + hq) * 256 + bin];
}
DI void tk_scan(const int* hist, int* res, int hq, int hl, int K) {
  int psum = 0;
#pragma unroll
  for (int x = 0; x < 16; ++x) psum += tk_cnt(hist, hq, 16 * hl + x);
  int inc = psum;
#pragma unroll
  for (int d = 1; d < 16; d <<= 1) { const int t = __shfl_up(inc, d, 16); if (hl >= d) inc += t; }
  const int e = inc - psum;
  if (e < K && K <= inc) {
    int run = e, found = 0, fb = 0, fk = 0, fc = 0;
    for (int x = 0; x < 16; ++x) {
      const int cnt = tk_cnt(hist, hq, 16 * hl + x);
      if (!found && K <= run + cnt) { found = 1; fb = 16 * hl + x; fk = K - run; fc = cnt; }
      run += cnt;
    }
    res[hq * 4 + 0] = fb; res[hq * 4 + 1] = fk; res[hq * 4 + 2] = fc;
  }
}

DI void topk_item(const Params& p, char* smem, int item) {
  __syncthreads();
  const int qq = item & 3, rest = item >> 2, b = rest & 7, c = 31 - (rest >> 3);
  const int q0 = c * 64 + qq * 16;
  const int ntw = c + 1;
  char* R = p.ws + OFF_R;
  const bf16_t* qi = (const bf16_t*)(R + 48 * MiB);
  const bf16_t* kib = (const bf16_t*)(R + 64 * MiB);
  unsigned* sel = (unsigned*)(R + 66 * MiB);
  const float* wif = (const float*)(p.ws + OFF_MISC + 3 * MiB);
  const int blk = blockIdx.x;
  unsigned* scr = (unsigned*)((blk < 256) ? (p.ws + OFF_X + (size_t)blk * 131072) : (R + 70 * MiB + (size_t)(blk - 256) * 131072));
  int* hist = (int*)smem;
  bf16_t* qs = (bf16_t*)(smem + 16384);
  int* res = (int*)(smem + 65600);
  const int tid = TIDX(), lane = tid & 63, w = tid >> 6, qn = lane & 15, g = lane >> 4;
#pragma unroll
  for (int it = 0; it < 4; ++it) {
    const int e = tid + 256 * it, hd = e >> 7, rem = e & 127, q = rem >> 3, c8 = rem & 7;
    const uint4 v = *(const uint4*)(qi + ((size_t)(b * 8 + hd) * S + q0 + q) * 64 + c8 * 8);
    *(uint4*)(qs + (hd * 16 + q) * 72 + c8 * 8) = v;
  }
  __syncthreads();
  {
    float wq0, wq1, wq2, wq3, wq4, wq5, wq6, wq7;
    const float4* wp = (const float4*)(wif + (size_t)(b * S + q0 + qn) * 8);
    const float4 wa = wp[0], wb = wp[1];
    wq0 = wa.x; wq1 = wa.y; wq2 = wa.z; wq3 = wa.w; wq4 = wb.x; wq5 = wb.y; wq6 = wb.z; wq7 = wb.w;
    const bf16_t* qsl = qs + qn * 72 + 8 * g;
#define TK_HEAD(hd_, wq_)                                                                         \
  {                                                                                               \
    const bf16x8 f0_ = *(const bf16x8*)(qsl + (hd_) * 16 * 72), f1_ = *(const bf16x8*)(qsl + (hd_) * 16 * 72 + 32); \
    f32x4 s_ = MFMA16(a0, f0_, z);                                                                \
    s_ = MFMA16(a1, f1_, s_);                                                                     \
    acc0 += (wq_) * fmaxf(s_[0], 0.f); acc1 += (wq_) * fmaxf(s_[1], 0.f);                         \
    acc2 += (wq_) * fmaxf(s_[2], 0.f); acc3 += (wq_) * fmaxf(s_[3], 0.f);                         \
  }
#pragma unroll 1
    for (int jt0 = 0; jt0 < ntw; jt0 += 4) {
      bf16x8 ka0[4], ka1[4];
#pragma unroll
      for (int u = 0; u < 4; ++u) {
        const int jt = (jt0 + u < ntw) ? (jt0 + u) : (ntw - 1);
        const bf16_t* kp = kib + (size_t)(b * S + 16 * (w + 4 * jt) + qn) * 64 + 8 * g;
        ka0[u] = *(const bf16x8*)kp; ka1[u] = *(const bf16x8*)(kp + 32);
      }
#pragma unroll
      for (int u = 0; u < 4; ++u) {
        if (jt0 + u < ntw) {
          const int kt = w + 4 * (jt0 + u);
          const bf16x8 a0 = ka0[u], a1 = ka1[u];
          const f32x4 z = {0.f, 0.f, 0.f, 0.f};
          float acc0 = 0.f, acc1 = 0.f, acc2 = 0.f, acc3 = 0.f;
          TK_HEAD(0, wq0) TK_HEAD(1, wq1) TK_HEAD(2, wq2) TK_HEAD(3, wq3)
          TK_HEAD(4, wq4) TK_HEAD(5, wq5) TK_HEAD(6, wq6) TK_HEAD(7, wq7)
          uint4 o; o.x = tokey(acc0); o.y = tokey(acc1); o.z = tokey(acc2); o.w = tokey(acc3);
          *(uint4*)(scr + qn * 2048 + 16 * kt + 4 * g) = o;
        }
      }
    }
#undef TK_HEAD
  }
  __syncthreads();
  const int hq = tid >> 4, hl = tid & 15;
  const unsigned* srow = scr + hq * 2048 + 4 * hl;
  uint4 kv[32];
#pragma unroll
  for (int j = 0; j < 32; ++j) kv[j] = (j < ntw) ? *(const uint4*)(srow + 64 * j) : make_uint4(0u, 0u, 0u, 0u);
  int* hcp = hist + ((hl & 3) * 16 + hq) * 256;
#define TK_ZERO_HIST() { _Pragma("unroll") for (int it = 0; it < 16; ++it) ((uint4*)hist)[tid + 256 * it] = make_uint4(0u, 0u, 0u, 0u); }
#define TK_FOREACH(BODY)                                                                   \
  _Pragma("unroll") for (int j = 0; j < 32; ++j) {                                         \
    if (j < ntw) {                                                                         \
      const unsigned uu_[4] = {kv[j].x, kv[j].y, kv[j].z, kv[j].w};                        \
      _Pragma("unroll") for (int e = 0; e < 4; ++e) { const unsigned u = uu_[e]; const int idx = 64 * j + 4 * hl + e; (void)idx; BODY }  \
    }                                                                                      \
  }
  unsigned prefix = 0;
  int Krem = 256, ceq = 0;
#pragma unroll 1
  for (int pass = 0; pass < 4; ++pass) {
    const int shift = 24 - 8 * pass;
    __syncthreads();
    TK_ZERO_HIST();
    __syncthreads();
    const unsigned pmask = (pass == 0) ? 0u : (0xffffffffu << (shift + 8));
    const unsigned pval = prefix << ((shift + 8) & 31);
    TK_FOREACH( if ((u & pmask) == (pval & pmask)) atomicAdd(&hcp[255 - ((u >> shift) & 255u)], 1); )
    __syncthreads();
    tk_scan(hist, res, hq, hl, Krem);
    __syncthreads();
    prefix = (prefix << 8) | (unsigned)(255 - res[hq * 4 + 0]);
    Krem = res[hq * 4 + 1];
    ceq = res[hq * 4 + 2];
  }
  const unsigned Tq = prefix;
  const int need = Krem;
  int Jlast = 4095;
  if (__syncthreads_or(ceq != need)) {
    TK_ZERO_HIST();
    __syncthreads();
    TK_FOREACH( if (u == Tq) atomicAdd(&hcp[idx >> 3], 1); )
    __syncthreads();
    tk_scan(hist, res, hq, hl, need);
    __syncthreads();
    const int binB = res[hq * 4 + 0], k2 = res[hq * 4 + 1];
    __syncthreads();
    TK_ZERO_HIST();
    __syncthreads();
    TK_FOREACH( if (u == Tq && (idx >> 3) == binB) atomicAdd(&hcp[idx & 7], 1); )
    __syncthreads();
    tk_scan(hist, res, hq, hl, k2);
    __syncthreads();
    Jlast = binB * 8 + res[hq * 4 + 0];
  }
#pragma unroll
  for (int j = 0; j < 32; ++j) {
    if (j < ntw) {
      const unsigned uu_[4] = {kv[j].x, kv[j].y, kv[j].z, kv[j].w};
      unsigned word = 0;
#pragma unroll
      for (int e = 0; e < 4; ++e) {
        const int idx = 64 * j + 4 * hl + e;
        const bool sl = (uu_[e] > Tq) || (uu_[e] == Tq && idx <= Jlast);
        word |= sl ? (1u << ((hl & 7) * 4 + e)) : 0u;
      }
      word |= __shfl_xor(word, 1); word |= __shfl_xor(word, 2); word |= __shfl_xor(word, 4);
      if ((hl & 7) == 0) sel[(size_t)(b * S + q0 + hq) * 64 + 2 * j + (hl >> 3)] = word;
    }
  }
#undef TK_FOREACH
#undef TK_ZERO_HIST
}

DI void phase_prologue(const Params& p, char* smem) {
  const int nb = gridDim.x, bid = blockIdx.x, tid = TIDX();
  const float* x = p.in[0];
  bf16_t* xb = (bf16_t*)(p.ws + OFF_XB);
  float* cs = (float*)(p.ws + OFF_MISC);
  const int n_xb = T * 1024 / 8192, n_cs = T * 16 / 256, n_cv = conv_mix_count(0);
  for (int it = bid; it < n_xb + n_cs + n_cv; it += nb) {
    if (it < n_xb) {
      float4 v0[4], v1[4];
#pragma unroll
      for (int u = 0; u < 4; ++u) { const size_t e = (size_t)it * 8192 + u * 2048 + tid * 8; v0[u] = *(const float4*)(x + e); v1[u] = *(const float4*)(x + e + 4); }
#pragma unroll
      for (int u = 0; u < 4; ++u) {
        const size_t e = (size_t)it * 8192 + u * 2048 + tid * 8;
        uint4 o; o.x = pack2(v0[u].x, v0[u].y); o.y = pack2(v0[u].z, v0[u].w); o.z = pack2(v1[u].x, v1[u].y); o.w = pack2(v1[u].z, v1[u].w);
        *(uint4*)(xb + e) = o;
      }
    } else if (it < n_xb + n_cs) {
      const int e = (it - n_xb) * 256 + tid, t = e >> 4, jf = e & 15;
      const float freq = __builtin_amdgcn_exp2f(-(float)jf * 0.8304820237218406f);
      const float ang = (float)p.pos[t] * freq;
      double rev = (double)ang * 0.15915494309189535;
      rev -= floor(rev);
      const float rf = (float)rev;
      cs[t * 32 + jf] = __builtin_amdgcn_cosf(rf);
      cs[t * 32 + 16 + jf] = __builtin_amdgcn_sinf(rf);
    } else {
      conv_mix_item(p, smem, 0, it - n_xb - n_cs);
    }
  }
}

DI void phase_final(const Params& p) {
  const float* x = (const float*)(p.ws + OFF_X);
  const float* g = p.in[23];
  const int lane = TIDX() & 63, w = TIDX() >> 6;
  float4 gv[4];
#pragma unroll
  for (int q = 0; q < 4; ++q) gv[q] = *(const float4*)(g + (lane + 64 * q) * 4);
  for (int row0 = (blockIdx.x * 4 + w) * 4; row0 < T; row0 += gridDim.x * 16) {
    float4 v[4][4];
#pragma unroll
    for (int rr = 0; rr < 4; ++rr)
#pragma unroll
      for (int q = 0; q < 4; ++q) v[rr][q] = *(const float4*)(x + (size_t)(row0 + rr) * 1024 + (lane + 64 * q) * 4);
#pragma unroll
    for (int rr = 0; rr < 4; ++rr) {
      float ss = 0.f;
#pragma unroll
      for (int q = 0; q < 4; ++q) ss += v[rr][q].x * v[rr][q].x + v[rr][q].y * v[rr][q].y + v[rr][q].z * v[rr][q].z + v[rr][q].w * v[rr][q].w;
#pragma unroll
      for (int o = 1; o < 64; o <<= 1) ss += __shfl_xor(ss, o);
      const float rstd = rsqrtf(ss * (1.f / 1024.f) + EPSV);
#pragma unroll
      for (int q = 0; q < 4; ++q) {
        float4 o; o.x = v[rr][q].x * rstd * gv[q].x; o.y = v[rr][q].y * rstd * gv[q].y; o.z = v[rr][q].z * rstd * gv[q].z; o.w = v[rr][q].w * rstd * gv[q].w;
        *(float4*)(p.out + (size_t)(row0 + rr) * 1024 + (lane + 64 * q) * 4) = o;
      }
    }
  }
}

struct EpiResid {
  const float* xin;
  float* xout;
  bf16_t* xb;
  DI void operator()(int rb, int cb, const f32x16& c0, const f32x16& c1, const float*) const {
    const int lane = TIDX() & 63, r = lane & 31, h = lane >> 5;
    bf16_t r0[16], r1[16];
#pragma unroll
    for (int i = 0; i < 16; ++i) { const size_t o = (size_t)(rb + CROW(i, h)) * 1024 + cb + r; r0[i] = xb[o]; r1[i] = xb[o + 32]; }
    __builtin_amdgcn_sched_barrier(0);
    float x0[16], x1[16];
#pragma unroll
    for (int i = 0; i < 16; ++i) { x0[i] = bf2f(r0[i]); x1[i] = bf2f(r1[i]); }
#pragma unroll
    for (int i = 0; i < 16; ++i) {
      const size_t o = (size_t)(rb + CROW(i, h)) * 1024 + cb + r;
      const float v0 = x0[i] + c0[i], v1 = x1[i] + c1[i];
      if (xout) { xout[o] = v0; xout[o + 32] = v1; }
      xb[o] = f2bf(v0); xb[o + 32] = f2bf(v1);
    }
  }
};

DI void phase_resid_gemm(const Params& p, char* smem, const bf16_t* a0, int lda0, const bf16_t* a1, int lda1, int ksplit,
                         const bf16_t* Wt, int K, const float* xin, bool write_f32) {
  EpiResid epi{xin, write_f32 ? (float*)(p.ws + OFF_X) : nullptr, (bf16_t*)(p.ws + OFF_XB)};
  if (ksplit >= K) {
    for (int it = blockIdx.x; it < 512; it += gridDim.x) {
      const int nt = (it >> 3) & 7, mt = ((it >> 6) << 3) | (it & 7);
      gemm_tile_big<false>(smem, a0, lda0, Wt, K, mt * 256, nt * 128, 0.f, epi);
    }
  } else {
    for (int it = blockIdx.x; it < 512; it += gridDim.x) {
      const int nt = (it >> 3) & 7, mt = ((it >> 6) << 3) | (it & 7);
      gemm_tile_big<false>(smem, a0, lda0, Wt, K, mt * 256, nt * 128, 0.f, epi, a1, ksplit);
    }
  }
}

DI void phase_E1(const Params& p, char* smem, int l) {
  char* R = p.ws + OFF_R;
  bf16_t* xr = (bf16_t*)R; bf16_t* gg = (bf16_t*)(R + 16 * MiB); bf16_t* cqb = (bf16_t*)(R + 32 * MiB); bf16_t* ckvb = (bf16_t*)(R + 40 * MiB);
  bf16_t* Kb = (bf16_t*)(R + 44 * MiB);
  const float* cs = (const float*)(p.ws + OFF_MISC);
  const bf16_t* xb = (const bf16_t*)(p.ws + OFF_XB);
  const bf16_t* Wt = (const bf16_t*)(p.ws + OFF_WMIX);
  auto epi = [=](int rb, int cb, const f32x16& c0, const f32x16& c1, const float* rsp) __attribute__((always_inline)) {
    const int lane = TIDX() & 63, r = lane & 31, h = lane >> 5;
    if (cb < 512) {
#pragma unroll
      for (int i = 0; i < 16; ++i) { const int cr = CROW(i, h); const float s = rsp[cr]; const size_t o = (size_t)(rb + cr) * 512 + cb + r; xr[o] = f2bf(c0[i] * s); xr[o + 32] = f2bf(c1[i] * s); }
    } else if (cb < 1024) {
#pragma unroll
      for (int i = 0; i < 16; ++i) { const int cr = CROW(i, h); const float s = rsp[cr]; const size_t o = (size_t)(rb + cr) * 512 + (cb - 512) + r; gg[o] = f2bf(gelu_tanh(c0[i] * s)); gg[o + 32] = f2bf(gelu_tanh(c1[i] * s)); }
    } else if (cb < 1280) {
#pragma unroll
      for (int i = 0; i < 16; ++i) { const int cr = CROW(i, h); const float s = rsp[cr]; const size_t o = (size_t)(rb + cr) * 256 + (cb - 1024) + r; cqb[o] = f2bf(c0[i] * s); cqb[o + 32] = f2bf(c1[i] * s); }
    } else if (cb < 1408) {
#pragma unroll
      for (int i = 0; i < 16; ++i) { const int cr = CROW(i, h); const float s = rsp[cr]; const size_t o = (size_t)(rb + cr) * 128 + (cb - 1280) + r; ckvb[o] = f2bf(c0[i] * s); ckvb[o + 32] = f2bf(c1[i] * s); }
    } else if (cb == 1408) {
      float ccv[16], snv[16];
#pragma unroll
      for (int i = 0; i < 16; ++i) { const int row = rb + CROW(i, h); ccv[i] = cs[row * 32 + (r & 15)]; snv[i] = cs[row * 32 + 16 + (r & 15)]; }
#pragma unroll
      for (int i = 0; i < 16; ++i) {
        const int cr = CROW(i, h); const int row = rb + cr;
        const float v = c0[i] * rsp[cr];
        const float pv = __shfl_xor(v, 16);
        const float cc = ccv[i], sn = snv[i];
        const float o = (r < 16) ? (v * cc - pv * sn) : (pv * sn + v * cc);
        const int b = row >> 11, s = row & 2047;
        const bf16_t ob = f2bf(o);
#pragma unroll
        for (int hd = 0; hd < 8; ++hd) Kb[((size_t)(b * 8 + hd) * S + s) * 96 + 64 + r] = ob;
      }
    }
  };
  const int ng = 1024;
  for (int it = blockIdx.x; it < ng; it += gridDim.x) {
    if (it < 512) { const int nt = (it >> 3) & 7, mt = ((it >> 6) << 3) | (it & 7); gemm_tile_big<true>(smem, xb, 1024, Wt, 1024, mt * 256, nt * 128, 1.f / 1024.f, epi); }
    else { const int i2 = it - 512; const int nt = 8 + (i2 >> 7), mt = i2 & 127; gemm_tile<true>(smem, xb, 1024, xb, 1024, 1 << 30, Wt, 1024, mt * 128, nt * 128, 1.f / 1024.f, epi); }
  }
}

DI void phase_E2(const Params& p, char* smem, int l) {
  char* R = p.ws + OFF_R;
  const bf16_t* cqb = (const bf16_t*)(R + 32 * MiB); const bf16_t* ckvb = (const bf16_t*)(R + 40 * MiB);
  bf16_t* Qb = (bf16_t*)(p.ws + OFF_X);
  bf16_t* Kb = (bf16_t*)(R + 44 * MiB); bf16_t* Vt = (bf16_t*)(R + 68 * MiB);
  const float* cs = (const float*)(p.ws + OFF_MISC);
  const bf16_t* WuqT = (const bf16_t*)(p.ws + OFF_WMIX + 3 * MiB);
  const bf16_t* WukvT = (const bf16_t*)(p.ws + OFF_WMIX + 3 * MiB + 512 * 1024);
  const float qscale = 0.10206207261596575f * LOG2E;
  auto epi_q = [=](int rb, int cb, const f32x16& c0, const f32x16& c1, const float* rsp) __attribute__((always_inline)) {
    const int lane = TIDX() & 63, r = lane & 31, h = lane >> 5;
#pragma unroll
    for (int ni = 0; ni < 2; ++ni) {
      const int col = cb + 32 * ni + r;
      const int hd = col / 96, dd = col - hd * 96;
      const bool rope = (((cb >> 5) + ni) % 3) == 2;
#pragma unroll
      for (int i0 = 0; i0 < 16; i0 += 8) {
      float ccv[8], snv[8];
      if (rope) {
#pragma unroll
        for (int i = 0; i < 8; ++i) { const int row = rb + CROW(i0 + i, h); ccv[i] = cs[row * 32 + (r & 15)]; snv[i] = cs[row * 32 + 16 + (r & 15)]; }
      }
#pragma unroll
      for (int i = i0; i < i0 + 8; ++i) {
        const int cr = CROW(i, h); const int row = rb + cr;
        float v = (ni ? c1[i] : c0[i]) * rsp[cr];
        if (rope) {
          const float pv = __shfl_xor(v, 16);
          const float cc = ccv[i - i0], sn = snv[i - i0];
          v = (r < 16) ? (v * cc - pv * sn) : (pv * sn + v * cc);
        }
        const int b = row >> 11, s = row & 2047;
        Qb[((size_t)(b * 8 + hd) * S + s) * 96 + dd] = f2bf(v * qscale);
      }
      }
    }
  };
  auto epi_kv = [=](int rb, int cb, const f32x16& c0, const f32x16& c1, const float* rsp) __attribute__((always_inline)) {
    const int lane = TIDX() & 63, r = lane & 31, h = lane >> 5;
    const int hd = cb >> 7;
    const int b = rb >> 11, s0 = rb & 2047;
    if ((cb & 127) < 64) {
#pragma unroll
      for (int i = 0; i < 16; ++i) {
        const int cr = CROW(i, h); const float sc = rsp[cr];
        const size_t o = ((size_t)(b * 8 + hd) * S + s0 + cr) * 96 + (cb & 127) + r;
        Kb[o] = f2bf(c0[i] * sc); Kb[o + 32] = f2bf(c1[i] * sc);
      }
    } else {
#pragma unroll
      for (int ni = 0; ni < 2; ++ni) {
        const int dd = (cb & 127) - 64 + 32 * ni + r;
#pragma unroll
        for (int g4 = 0; g4 < 4; ++g4) {
          const int cr = 8 * g4 + 4 * h;
          float v[4];
#pragma unroll
          for (int q = 0; q < 4; ++q) v[q] = (ni ? c1[4 * g4 + q] : c0[4 * g4 + q]) * rsp[cr + q];
          uint2 o; o.x = pack2(v[0], v[1]); o.y = pack2(v[2], v[3]);
          *(uint2*)(Vt + ((size_t)(b * 8 + hd) * 64 + dd) * S + s0 + cr) = o;
        }
      }
    }
  };
  const int nq = 128 * 6, nkv = 128 * 8, nl = 2048;
  for (int it = blockIdx.x; it < nq + nkv + nl + CONV_MLP_ITEMS; it += gridDim.x) {
    if (it >= nq + nkv + nl) { conv_mlp_item(p, smem, l, it - nq - nkv - nl); continue; }
    if (it < nq) { const int nt = it >> 7, mt = it & 127; gemm_tile<true>(smem, cqb, 256, cqb, 256, 1 << 30, WuqT, 256, mt * 128, nt * 128, 1.f / 256.f, epi_q); }
    else if (it < nq + nkv) { const int i2 = it - nq; const int nt = i2 >> 7, mt = i2 & 127; gemm_tile<true>(smem, ckvb, 128, ckvb, 128, 1 << 30, WukvT, 128, mt * 128, nt * 128, 1.f / 128.f, epi_kv); }
    else lru1_item(p, smem, l >> 1, it - nq - nkv);
  }
}

DI void phase_E3(const Params& p, char* smem) {
  char* R = p.ws + OFF_R;
  const bf16_t* Qb = (const bf16_t*)(p.ws + OFF_X);
  const bf16_t* Kb = (const bf16_t*)(R + 44 * MiB); const bf16_t* Vt = (const bf16_t*)(R + 68 * MiB);
  bf16_t* ymla = (bf16_t*)R;
  const int w = TIDX() >> 6;
  for (int it0 = blockIdx.x; it0 < 1024 + 256; it0 += gridDim.x) {
    const int pos = it0 - 256;
    const int it = (it0 < 256) ? (1024 + it0) : ((pos < 512) ? pos : (1535 - pos));
    if (it < 1024) {
      const int qb = 15 - (it >> 6), bh = it & 63, b = bh >> 3, hd = bh & 7;
      const bf16_t* Kg = Kb + (size_t)bh * S * 96;
      const bf16_t* Vg = Vt + (size_t)bh * 64 * S;
      const bf16_t* Qw = Qb + ((size_t)bh * S + qb * 128 + w * 32) * 96;
      bf16_t* op = ymla + (size_t)(b * S + qb * 128 + w * 32) * 512 + hd * 64;
      attn_core<96, 1, false>(smem, Kg, Vg, Qw, 2 * qb + 2, 2 * qb + 1 + (w >> 1), op, 512);
    } else lru2_item(p, smem, it - 1024);
  }
}

DI void phase_O1(const Params& p, char* smem, int l) {
  char* R = p.ws + OFF_R;
  bf16_t* Qd = (bf16_t*)R; bf16_t* Kd = (bf16_t*)(R + 32 * MiB); bf16_t* Vdt = (bf16_t*)(R + 40 * MiB);
  bf16_t* qi = (bf16_t*)(R + 48 * MiB); bf16_t* kib = (bf16_t*)(R + 64 * MiB);
  float* wif = (float*)(p.ws + OFF_MISC + 3 * MiB);
  const float* gk = p.in[18] + (l >> 1) * 64;
  const bf16_t* xb = (const bf16_t*)(p.ws + OFF_XB);
  const bf16_t* Wt = (const bf16_t*)(p.ws + OFF_WMIX);
  const float dscale = 0.125f * LOG2E;
  const float wscale = 0.35355339059327373f * 0.125f;
  auto epi = [=](int rb, int cb, const f32x16& c0, const f32x16& c1, const float* rsp) __attribute__((always_inline)) {
    const int lane = TIDX() & 63, r = lane & 31, h = lane >> 5;
    const int b = rb >> 11, s0 = rb & 2047;
    if (cb < 1024) {
      const int hd = cb >> 6;
#pragma unroll
      for (int i = 0; i < 16; ++i) { const int cr = CROW(i, h); const float sc = rsp[cr] * dscale; const size_t o = ((size_t)(b * 16 + hd) * S + s0 + cr) * 64 + r; Qd[o] = f2bf(c0[i] * sc); Qd[o + 32] = f2bf(c1[i] * sc); }
    } else if (cb < 1280) {
      const int g = (cb - 1024) >> 6;
#pragma unroll
      for (int i = 0; i < 16; ++i) { const int cr = CROW(i, h); const float sc = rsp[cr]; const size_t o = ((size_t)(b * 4 + g) * S + s0 + cr) * 64 + r; Kd[o] = f2bf(c0[i] * sc); Kd[o + 32] = f2bf(c1[i] * sc); }
    } else if (cb < 1536) {
      const int g = (cb - 1280) >> 6;
#pragma unroll
      for (int ni = 0; ni < 2; ++ni) {
        const int dd = 32 * ni + r;
#pragma unroll
        for (int g4 = 0; g4 < 4; ++g4) {
          const int cr = 8 * g4 + 4 * h;
          float v[4];
#pragma unroll
          for (int q = 0; q < 4; ++q) v[q] = (ni ? c1[4 * g4 + q] : c0[4 * g4 + q]) * rsp[cr + q];
          uint2 o; o.x = pack2(v[0], v[1]); o.y = pack2(v[2], v[3]);
          *(uint2*)(Vdt + ((size_t)(b * 4 + g) * 64 + dd) * S + s0 + cr) = o;
        }
      }
    } else if (cb < 2048) {
      const int hi = (cb - 1536) >> 6;
#pragma unroll
      for (int i = 0; i < 16; ++i) { const int cr = CROW(i, h); const float sc = rsp[cr]; const size_t o = ((size_t)(b * 8 + hi) * S + s0 + cr) * 64 + r; qi[o] = f2bf(c0[i] * sc); qi[o + 32] = f2bf(c1[i] * sc); }
    } else if (cb == 2048) {
      const float g0 = gk[r], g1 = gk[32 + r];
#pragma unroll
      for (int i = 0; i < 16; ++i) {
        const int cr = CROW(i, h); const float sc = rsp[cr];
        const float v0 = c0[i] * sc, v1 = c1[i] * sc;
        float ss = v0 * v0 + v1 * v1;
        ss += __shfl_xor(ss, 1); ss += __shfl_xor(ss, 2); ss += __shfl_xor(ss, 4); ss += __shfl_xor(ss, 8); ss += __shfl_xor(ss, 16);
        const float rk = rsqrtf(ss * (1.f / 64.f) + EPSV);
        const size_t o = (size_t)(rb + cr) * 64 + r;
        kib[o] = f2bf(v0 * rk * g0); kib[o + 32] = f2bf(v1 * rk * g1);
      }
    } else if (cb == 2112) {
      if (r < 8) {
#pragma unroll
        for (int i = 0; i < 16; ++i) { const int cr = CROW(i, h); wif[(size_t)(rb + cr) * 8 + r] = c0[i] * rsp[cr] * wscale; }
      }
    }
  };
  const int ng = 1024 + 128;
  for (int it = blockIdx.x; it < ng + CONV_MLP_ITEMS; it += gridDim.x) {
    if (it < 1024) { const int i9 = it & 511; const int nt = ((it >> 9) << 3) | ((i9 >> 3) & 7), mt = ((i9 >> 6) << 3) | (i9 & 7); gemm_tile_big<true>(smem, xb, 1024, Wt, 1024, mt * 256, nt * 128, 1.f / 1024.f, epi); }
    else if (it < ng) { const int mt = it - 1024; gemm_tile<true>(smem, xb, 1024, xb, 1024, 1 << 30, Wt, 1024, mt * 128, 16 * 128, 1.f / 1024.f, epi); }
    else conv_mlp_item(p, smem, l, it - ng);
  }
}

DI void phase_O3(const Params& p, char* smem) {
  char* R = p.ws + OFF_R;
  const bf16_t* Qd = (const bf16_t*)R; const bf16_t* Kd = (const bf16_t*)(R + 32 * MiB); const bf16_t* Vdt = (const bf16_t*)(R + 40 * MiB);
  const unsigned* sel = (const unsigned*)(R + 66 * MiB);
  bf16_t* yd = (bf16_t*)(R + 70 * MiB);
  unsigned* maskl = (unsigned*)(smem + 22016);
  const int tid = TIDX(), w = tid >> 6;
  for (int it0 = blockIdx.x; it0 < 1024; it0 += gridDim.x) {
    const int it = (it0 < 512) ? it0 : (1535 - it0);
    const int c = 31 - (it >> 5), bg = it & 31, b = bg >> 2, g = bg & 3;
    const bool use_mask = c >= 4;
    __syncthreads();
    {
      const int nw = 2 * (c + 1);
      unsigned mv[16];
#pragma unroll
      for (int i = 0; i < 16; ++i) { const int e = tid + 256 * i, q = e >> 6, wd = e & 63; mv[i] = (use_mask && wd < nw) ? sel[(size_t)(b * S + c * 64 + q) * 64 + wd] : 0xffffffffu; }
#pragma unroll
      for (int i = 0; i < 16; ++i) { const int e = tid + 256 * i, q = e >> 6, wd = e & 63; if (wd < nw) maskl[q * 65 + wd] = mv[i]; }
    }
    const int head = 4 * g + w;
    const bf16_t* Kg = Kd + (size_t)bg * S * 64;
    const bf16_t* Vg = Vdt + (size_t)bg * 64 * S;
    const bf16_t* Qw = Qd + ((size_t)(b * 16 + head) * S + c * 64) * 64;
    bf16_t* op = yd + (size_t)(b * S + c * 64) * 1024 + head * 64;
    attn_core<64, 2, true>(smem, Kg, Vg, Qw, c + 1, c + 1, op, 1024);
  }
}

DI void phase_M1(const Params& p, char* smem, int l) {
  const bf16_t* xb = (const bf16_t*)(p.ws + OFF_XB);
  const bf16_t* W1t = (const bf16_t*)(p.ws + OFF_WMLP);
  bf16_t* a = (bf16_t*)(p.ws + OFF_R);
  auto epi = [=](int rb, int cb, const f32x16& c0, const f32x16& c1, const float* rsp) __attribute__((always_inline)) {
    const int lane = TIDX() & 63, r = lane & 31, h = lane >> 5;
#pragma unroll
    for (int i = 0; i < 16; ++i) {
      const int cr = CROW(i, h); const float sc = rsp[cr];
      const size_t o = (size_t)(rb + cr) * 4096 + cb + r;
      const float v0 = fmaxf(c0[i] * sc, 0.f), v1 = fmaxf(c1[i] * sc, 0.f);
      a[o] = f2bf(v0 * v0); a[o + 32] = f2bf(v1 * v1);
    }
  };
  const int ng = 64 * 32;
  const int ncv = (l < 3) ? conv_mix_count(l + 1) : 0;
  for (int it = blockIdx.x; it < ng + ncv; it += gridDim.x) {
    if (it < ng) { const int i9 = it & 511; const int nt = ((it >> 9) << 3) | ((i9 >> 3) & 7), mt = ((i9 >> 6) << 3) | (i9 & 7); gemm_tile_big<true>(smem, xb, 1024, W1t, 1024, mt * 256, nt * 128, 1.f / 1024.f, epi); }
    else conv_mix_item(p, smem, l + 1, it - ng);
  }
}

DI void run_phase(const Params& p, int ph, char* smem) {
#ifndef PHM
#define PHM 0xffff
#endif
  if (ph == 0) { if (PHM & 1) phase_prologue(p, smem); return; }
  if (ph == NPHASE - 1) { if (PHM & 2) phase_final(p); return; }
  const int l = (ph - 1) / 6, sub = (ph - 1) - l * 6;
  const bool odd = l & 1;
  char* R = p.ws + OFF_R;
  const float* xcur = (l == 0) ? p.in[0] : nullptr;
  switch (sub) {
    case 0: if (odd) { if (PHM & 4) phase_O1(p, smem, l); } else { if (PHM & 8) phase_E1(p, smem, l); } break;
    case 1:
      if (odd) { if (PHM & 16) for (int it0 = blockIdx.x; it0 < 896; it0 += gridDim.x) topk_item(p, smem, (it0 < 512) ? it0 : (1407 - it0)); }
      else { if (PHM & 32) phase_E2(p, smem, l); }
      break;
    case 2: if (odd) { if (PHM & 64) phase_O3(p, smem); } else { if (PHM & 128) phase_E3(p, smem); } break;
    case 3:
      if (!(PHM & 512)) break;
      if (odd) phase_resid_gemm(p, smem, (const bf16_t*)(R + 70 * MiB), 1024, (const bf16_t*)(R + 70 * MiB), 1024, 1 << 30,
                                (const bf16_t*)(p.ws + OFF_WMIX + 4 * MiB + 512 * 1024), 1024, xcur, false);
      else phase_resid_gemm(p, smem, (const bf16_t*)(R + 100 * MiB), 512, (const bf16_t*)R, 512, 512,
                            (const bf16_t*)(p.ws + OFF_WMIX + 4 * MiB), 1024, xcur, false);
      break;
    case 4: if (PHM & 256) phase_M1(p, smem, l); break;
    case 5: phase_resid_gemm(p, smem, (const bf16_t*)R, 4096, (const bf16_t*)R, 4096, 1 << 30, (const bf16_t*)(p.ws + OFF_WMLP + 8 * MiB), 4096,
                             nullptr, l == 3); break;
  }
}


#define XB_TMO      128
#define XB_XCNT(j)  (256  + 64 * (j))
#define XB_XSUB(j)  (1280 + 64 * (j))
#define XB_XGEN(j)  (2304 + 64 * (j))
#define XB_TOP      3328
#define XB_TOPGEN   3392
#define XCD_BAR_WORDS 3456
#define XB_SPIN_CAP (1u << 22)
#define LAS __attribute__((address_space(3)))
DI unsigned xb_ld(unsigned* p)              { return __hip_atomic_load(p, __ATOMIC_RELAXED, __HIP_MEMORY_SCOPE_AGENT); }
DI unsigned xb_add(unsigned* p, unsigned v) { return __hip_atomic_fetch_add(p, v, __ATOMIC_RELAXED, __HIP_MEMORY_SCOPE_AGENT); }
DI unsigned xb_xcc_id() { return (unsigned)__builtin_amdgcn_s_getreg((3 << 11) | 20) & 0xFu; }
#define XB_SPIN(cond, bar) do { unsigned _sp = 0; while (cond) { __builtin_amdgcn_s_sleep(1); \
    if ((++_sp & 255u) == 0u) { if (xb_ld(&(bar)[XB_TMO])) break; if (_sp > XB_SPIN_CAP) { atomicAdd(&(bar)[XB_TMO], 1u); break; } } } } while (0)
struct XcdBarrier { unsigned* bar; unsigned x; volatile LAS unsigned* st; };
DI XcdBarrier xcd_barrier_post(unsigned* bar, volatile LAS unsigned* st) {
  XcdBarrier b; b.bar = bar; b.x = xb_xcc_id(); b.st = st;
  if (__builtin_amdgcn_workitem_id_x() == 0) (void)xb_add(&bar[XB_XCNT(b.x)], 1u);
  return b;
}
DI void xcd_barrier_complete(unsigned* bar, unsigned x, unsigned& nloc, unsigned& nx) {
  const unsigned G = gridDim.x * gridDim.y * gridDim.z;
  unsigned sum, cnt, mine, sp = 0u;
  for (;;) {
    sum = 0u; cnt = 0u; mine = 0u;
#pragma unroll
    for (unsigned j = 0; j < 16; ++j) { const unsigned c = xb_ld(&bar[XB_XCNT(j)]); sum += c; cnt += (c > 0u) ? 1u : 0u; mine = (j == x) ? c : mine; }
    if (sum == G) break;
    __builtin_amdgcn_s_sleep(1);
    if ((++sp & 255u) == 0u) { if (xb_ld(&bar[XB_TMO])) break; if (sp > XB_SPIN_CAP) { atomicAdd(&bar[XB_TMO], 1u); break; } }
  }
  nloc = mine > 0u ? mine : 1u; nx = cnt > 0u ? cnt : 1u;
}
DI void xcd_barrier(const XcdBarrier& b) {
  asm volatile("s_waitcnt vmcnt(0)" ::: "memory");
  __syncthreads();
  if (__builtin_amdgcn_workitem_id_x() == 0) {
    unsigned* bar = b.bar;
    __builtin_amdgcn_s_waitcnt(0);
    unsigned nloc = b.st[0], nx = b.st[1];
    if (nloc == 0u) { xcd_barrier_complete(bar, b.x, nloc, nx); b.st[0] = nloc; b.st[1] = nx; }
    const unsigned old = xb_add(&bar[XB_XSUB(b.x)], 1u);
    const unsigned gen = old / nloc;
    if (old + 1u == (gen + 1u) * nloc) {
      __builtin_amdgcn_fence(__ATOMIC_RELEASE, "agent");
      asm volatile("s_waitcnt vmcnt(0)" ::: "memory");
      const unsigned og = xb_add(&bar[XB_TOP], 1u);
      const unsigned tg = og / nx;
      if (og + 1u == (tg + 1u) * nx) xb_add(&bar[XB_TOPGEN], 1u);
      else XB_SPIN(xb_ld(&bar[XB_TOPGEN]) == tg, bar);
      __builtin_amdgcn_fence(__ATOMIC_ACQUIRE, "agent");
      xb_add(&bar[XB_XGEN(b.x)], 1u);
      asm volatile("s_waitcnt vmcnt(0)" ::: "memory");
    } else {
      XB_SPIN(xb_ld(&bar[XB_XGEN(b.x)]) == gen, bar);
      __builtin_amdgcn_fence(__ATOMIC_ACQUIRE, "agent");
      asm volatile("s_waitcnt vmcnt(0)" ::: "memory");
    }
  }
  __syncthreads();
}
constexpr size_t OFF_BAR = OFF_MISC + 4 * MiB;

__global__ void __launch_bounds__(256, 2) mega_kernel(Params p) {
  __shared__ __attribute__((aligned(16))) char smem[SMEM_BYTES];
  cg::grid_group grid = cg::this_grid();
  if (__builtin_amdgcn_workitem_id_x() == 0) *(uint4*)(smem + SMEM_BYTES - 16) = make_uint4(0u, 0u, 0u, 0u);
  __syncthreads();
  XcdBarrier xb = xcd_barrier_post((unsigned*)(p.ws + OFF_BAR), (volatile LAS unsigned*)(smem + SMEM_BYTES - 16));
  for (int ph = p.phase_lo; ph < p.phase_hi; ++ph) {
    if (ph > p.phase_lo) {
      if (p.pad0 != 0) grid.sync();
      xcd_barrier(xb);
    }
    run_phase(p, ph, smem);
#ifdef PROBE_SUB
    if (ph > 0 && ph < NPHASE - 1 && ((ph - 1) % 6) == PROBE_SUB && ((((ph - 1) / 6) & 1) == PROBE_ODD)) { xcd_barrier(xb); run_phase(p, ph, smem); }
#endif
  }
}

extern "C" void kernel_launch(void* const* d_in, const int* in_sizes, int n_in, void* d_out, int out_size, void* d_ws, size_t ws_size,
                              hipStream_t stream) {
  Params p;
  memset(&p, 0, sizeof(p));
  for (int i = 0; i < 24; ++i) p.in[i] = (const float*)d_in[i];
  p.pos = (const int*)d_in[1];
  p.out = (float*)d_out;
  p.ws = (char*)d_ws;
  static int grid_blocks = 0;
  if (!grid_blocks) {
    int dev = 0, cus = 0, per_cu = 0;
    hipGetDevice(&dev);
    hipDeviceGetAttribute(&cus, hipDeviceAttributeMultiprocessorCount, dev);
    hipOccupancyMaxActiveBlocksPerMultiprocessor(&per_cu, mega_kernel, 256, 0);
    if (per_cu > 2) per_cu = 2;
    if (per_cu < 1) per_cu = 1;
    grid_blocks = cus * per_cu;
  }
  (void)hipMemsetAsync((char*)d_ws + OFF_BAR, 0, XCD_BAR_WORDS * sizeof(unsigned), stream);
#if MULTI_LAUNCH
  for (int ph = 0; ph < NPHASE; ++ph) {
    p.phase_lo = ph; p.phase_hi = ph + 1;
    hipLaunchKernelGGL(mega_kernel, dim3(grid_blocks), dim3(256), 0, stream, p);
  }
#else
  p.phase_lo = 0; p.phase_hi = NPHASE;
  void* args[] = {&p};
  hipError_t e = hipLaunchCooperativeKernel((void*)mega_kernel, dim3(grid_blocks), dim3(256), args, 0, stream);
  if (e != hipSuccess) fprintf(stderr, "cooperative launch failed: %s (grid %d)\n", hipGetErrorString(e), grid_blocks);
#endif
}
```

```cpp
#include <hip/hip_runtime.h>
#include <hip/hip_cooperative_groups.h>
#include <stdint.h>
#include <string.h>
#include <stdio.h>
namespace cg = cooperative_groups;

#ifndef MULTI_LAUNCH
#define MULTI_LAUNCH 0
#endif

typedef __attribute__((ext_vector_type(8))) short bf16x8;
typedef __attribute__((ext_vector_type(16))) float f32x16;
typedef __attribute__((ext_vector_type(4))) float f32x4;
typedef unsigned short bf16_t;

#define DI __device__ __forceinline__
#define MFMA32(a, b, c) __builtin_amdgcn_mfma_f32_32x32x16_bf16((a), (b), (c), 0, 0, 0)
#define MFMA16(a, b, c) __builtin_amdgcn_mfma_f32_16x16x32_bf16((a), (b), (c), 0, 0, 0)
#define CROW(i, h) (((i) & 3) + 8 * ((i) >> 2) + 4 * (h))

constexpr int S = 2048, T = 16384;
constexpr float EPSV = 1e-6f;
constexpr float LOG2E = 1.4426950408889634f;
constexpr int NPHASE = 26;
constexpr int SMEM_BYTES = 66688;

constexpr size_t MiB = 1ull << 20;
constexpr size_t OFF_X = 0, OFF_XB = 64 * MiB, OFF_WMLP = 96 * MiB, OFF_WMIX = 112 * MiB, OFF_MISC = 119 * MiB, OFF_R = 124 * MiB;

struct Params {
  const float* in[24];
  const int* pos;
  float* out;
  char* ws;
  int phase_lo, phase_hi;
  int pad0, pad1;
};

DI int TIDX() { int t = __builtin_amdgcn_workitem_id_x(); asm volatile("" : "+v"(t)); return t; }
typedef __attribute__((ext_vector_type(2))) __bf16 bf2v_t;
typedef __attribute__((ext_vector_type(2))) float f2v_t;
DI bf16_t f2bf(float x) { __bf16 r = (__bf16)x; return __builtin_bit_cast(bf16_t, r); }
DI float bf2f(bf16_t b) { return __uint_as_float(((unsigned)b) << 16); }
DI unsigned pack2(float a, float b) { f2v_t v = {a, b}; bf2v_t r = __builtin_convertvector(v, bf2v_t); return __builtin_bit_cast(unsigned, r); }
DI float lo2f(unsigned v) { return __uint_as_float(v << 16); }
DI float hi2f(unsigned v) { return __uint_as_float(v & 0xffff0000u); }
DI f32x16 zero16() { f32x16 z;
#pragma unroll
  for (int i = 0; i < 16; ++i) z[i] = 0.f; return z; }
DI float sigmoidf_(float x) { return 1.f / (1.f + __expf(-x)); }
DI float gelu_tanh(float x) { float y = 0.7978845608028654f * (x + 0.044715f * x * x * x); float t = 1.f - 2.f / (__expf(2.f * y) + 1.f); return 0.5f * x * (1.f + t); }
DI float sumsq8(const uint4& v) {
  float s = 0.f;
  s += lo2f(v.x) * lo2f(v.x); s += hi2f(v.x) * hi2f(v.x);
  s += lo2f(v.y) * lo2f(v.y); s += hi2f(v.y) * hi2f(v.y);
  s += lo2f(v.z) * lo2f(v.z); s += hi2f(v.z) * hi2f(v.z);
  s += lo2f(v.w) * lo2f(v.w); s += hi2f(v.w) * hi2f(v.w);
  return s;
}

typedef __attribute__((ext_vector_type(2))) __bf16 bf2_t;
DI float sumsq_frag(const bf16x8& f, float acc) {
  const uint4 u = __builtin_bit_cast(uint4, f);
  acc = __builtin_amdgcn_fdot2_f32_bf16(__builtin_bit_cast(bf2_t, u.x), __builtin_bit_cast(bf2_t, u.x), acc, false);
  acc = __builtin_amdgcn_fdot2_f32_bf16(__builtin_bit_cast(bf2_t, u.y), __builtin_bit_cast(bf2_t, u.y), acc, false);
  acc = __builtin_amdgcn_fdot2_f32_bf16(__builtin_bit_cast(bf2_t, u.z), __builtin_bit_cast(bf2_t, u.z), acc, false);
  acc = __builtin_amdgcn_fdot2_f32_bf16(__builtin_bit_cast(bf2_t, u.w), __builtin_bit_cast(bf2_t, u.w), acc, false);
  return acc;
}

template <bool NORM, class Epi>
DI void gemm_tile(char* smem, const bf16_t* a0, int lda0, const bf16_t* a1, int lda1, int ksplit,
                  const bf16_t* Wt, int K, int m0, int n0, float inv_nk, Epi epi) {
  __syncthreads();
  float* rs = (float*)(smem + 65536);
  const int tid = TIDX(), lane = tid & 63, w = tid >> 6, r = lane & 31, h = lane >> 5, wm = w >> 1, wn = w & 1;
  const int nkt = K >> 6;
  const int grow = w * 8 + (lane >> 3);
  const int gch = ((lane & 7) ^ ((4 * (w & 1) + (lane >> 4)) & 7)) * 8;
  const bf16_t* bsrc = Wt + (size_t)(n0 + grow) * K + gch;
  const size_t bstep = (size_t)32 * K;
  auto glds = [&](int kt, int buf) __attribute__((always_inline)) {
    const int k = kt * 64;
    const bf16_t* ab; int lda;
    if (k < ksplit) { ab = a0 + k; lda = lda0; } else { ab = a1 + (k - ksplit); lda = lda1; }
    const bf16_t* asrc = ab + (size_t)(m0 + grow) * lda + gch;
    const size_t astep = (size_t)32 * lda;
    char* lb = smem + buf * 32768 + w * 1024;
    __builtin_amdgcn_global_load_lds((const unsigned*)(asrc), (__attribute__((address_space(3))) unsigned*)(lb), 16, 0, 0);
    __builtin_amdgcn_global_load_lds((const unsigned*)(asrc + astep), (__attribute__((address_space(3))) unsigned*)(lb + 4096), 16, 0, 0);
    __builtin_amdgcn_global_load_lds((const unsigned*)(asrc + 2 * astep), (__attribute__((address_space(3))) unsigned*)(lb + 8192), 16, 0, 0);
    __builtin_amdgcn_global_load_lds((const unsigned*)(asrc + 3 * astep), (__attribute__((address_space(3))) unsigned*)(lb + 12288), 16, 0, 0);
    __builtin_amdgcn_global_load_lds((const unsigned*)(bsrc + k), (__attribute__((address_space(3))) unsigned*)(lb + 16384), 16, 0, 0);
    __builtin_amdgcn_global_load_lds((const unsigned*)(bsrc + k + bstep), (__attribute__((address_space(3))) unsigned*)(lb + 16384 + 4096), 16, 0, 0);
    __builtin_amdgcn_global_load_lds((const unsigned*)(bsrc + k + 2 * bstep), (__attribute__((address_space(3))) unsigned*)(lb + 16384 + 8192), 16, 0, 0);
    __builtin_amdgcn_global_load_lds((const unsigned*)(bsrc + k + 3 * bstep), (__attribute__((address_space(3))) unsigned*)(lb + 16384 + 12288), 16, 0, 0);
  };
  f32x16 acc00 = zero16(), acc01 = zero16(), acc10 = zero16(), acc11 = zero16();
  float ss0 = 0.f, ss1 = 0.f;
  const int sw = (r >> 1) & 7;
  const int aoff = (wm * 64 + r) * 128, boff = 16384 + (wn * 64 + r) * 128;
  glds(0, 0);
  for (int kt = 0; kt < nkt; ++kt) {
    asm volatile("s_waitcnt vmcnt(0)" ::: "memory");
    asm volatile("s_waitcnt lgkmcnt(0)" ::: "memory");
    __builtin_amdgcn_s_barrier();
    const char* base = smem + (kt & 1) * 32768;
    bf16x8 af0[4], af1[4], bf0[4], bf1[4];
#pragma unroll
    for (int ks = 0; ks < 4; ++ks) {
      const int p = ((2 * ks + h) ^ sw) * 16;
      af0[ks] = *(const bf16x8*)(base + aoff + p); af1[ks] = *(const bf16x8*)(base + aoff + 4096 + p);
      bf0[ks] = *(const bf16x8*)(base + boff + p); bf1[ks] = *(const bf16x8*)(base + boff + 4096 + p);
    }
    __builtin_amdgcn_sched_barrier(0);
    if (kt + 1 < nkt) glds(kt + 1, (kt + 1) & 1);
    __builtin_amdgcn_sched_barrier(0);
#pragma unroll
    for (int ks = 0; ks < 4; ++ks) {
      if (NORM) { ss0 = sumsq_frag(af0[ks], ss0); ss1 = sumsq_frag(af1[ks], ss1); }
      acc00 = MFMA32(af0[ks], bf0[ks], acc00); acc01 = MFMA32(af0[ks], bf1[ks], acc01);
      acc10 = MFMA32(af1[ks], bf0[ks], acc10); acc11 = MFMA32(af1[ks], bf1[ks], acc11);
    }
  }
  if (NORM) {
    ss0 += __shfl_xor(ss0, 32); ss1 += __shfl_xor(ss1, 32);
    if (wn == 0 && h == 0) { rs[wm * 64 + r] = rsqrtf(ss0 * inv_nk + EPSV); rs[wm * 64 + 32 + r] = rsqrtf(ss1 * inv_nk + EPSV); }
    __syncthreads();
  }
  epi(m0 + wm * 64, n0 + wn * 64, acc00, acc01, rs + wm * 64);
  epi(m0 + wm * 64 + 32, n0 + wn * 64, acc10, acc11, rs + wm * 64 + 32);
}

template <bool NORM, class Epi>
DI void gemm_tile_big(char* smem, const bf16_t* A, int lda, const bf16_t* Wt, int K, int m0, int n0, float inv_nk, Epi epi,
                       const bf16_t* A2 = nullptr, int ksplit = 1 << 30) {
  __syncthreads();
  float* rs = (float*)(smem + 65536);
  const int tid = TIDX(), lane = tid & 63, w = tid >> 6, r = lane & 31, h = lane >> 5, wm = w >> 1, wn = w & 1;
  const int nkt = K >> 5;
  const int wu = __builtin_amdgcn_readfirstlane(w);
  const int grow = wu * 16 + (lane >> 2);
  const int gch = ((lane & 3) ^ ((lane >> 4) & 3)) * 8;
  const unsigned aoffl = (unsigned)(grow * lda + gch) * 2u;
  const unsigned boffl = (unsigned)(grow * K + gch) * 2u;
  const char* abase = (const char*)(A + (size_t)m0 * lda);
  const char* abase2 = A2 ? (const char*)(A2 + (size_t)m0 * lda) - (size_t)ksplit * 2 : abase;
  const char* bbase = (const char*)(Wt + (size_t)n0 * K);
  const size_t astep = (size_t)64 * lda * 2, bstep = (size_t)64 * K * 2;
  auto glds = [&](int kt, int buf) __attribute__((always_inline)) {
    const size_t kb = (size_t)kt * 64;
    char* lb = smem + buf * 24576 + wu * 1024;
    const char* u0 = ((kt * 32 < ksplit) ? abase : abase2) + kb; const char* u1 = u0 + astep; const char* u2 = u1 + astep; const char* u3 = u2 + astep;
    const char* v0 = bbase + kb; const char* v1 = v0 + bstep;
    asm volatile("" : "+s"(u0), "+s"(u1), "+s"(u2), "+s"(u3), "+s"(v0), "+s"(v1));
    __builtin_amdgcn_global_load_lds((const unsigned*)(u0 + (size_t)aoffl), (__attribute__((address_space(3))) unsigned*)(lb), 16, 0, 0);
    __builtin_amdgcn_global_load_lds((const unsigned*)(u1 + (size_t)aoffl), (__attribute__((address_space(3))) unsigned*)(lb + 4096), 16, 0, 0);
    __builtin_amdgcn_global_load_lds((const unsigned*)(u2 + (size_t)aoffl), (__attribute__((address_space(3))) unsigned*)(lb + 8192), 16, 0, 0);
    __builtin_amdgcn_global_load_lds((const unsigned*)(u3 + (size_t)aoffl), (__attribute__((address_space(3))) unsigned*)(lb + 12288), 16, 0, 0);
    __builtin_amdgcn_global_load_lds((const unsigned*)(v0 + (size_t)boffl), (__attribute__((address_space(3))) unsigned*)(lb + 16384), 16, 0, 0);
    __builtin_amdgcn_global_load_lds((const unsigned*)(v1 + (size_t)boffl), (__attribute__((address_space(3))) unsigned*)(lb + 16384 + 4096), 16, 0, 0);
  };
  f32x16 acc[4][2];
#pragma unroll
  for (int mt = 0; mt < 4; ++mt) { acc[mt][0] = zero16(); acc[mt][1] = zero16(); }
  float ss[4] = {0.f, 0.f, 0.f, 0.f};
  const int sw = (r >> 2) & 3;
  const int aoff = (wm * 128 + r) * 64, boff = 16384 + (wn * 64 + r) * 64;
  const int p0 = ((0 + h) ^ sw) * 16, p1 = ((2 + h) ^ sw) * 16;
  __builtin_amdgcn_s_waitcnt(0x0F70);
  glds(0, 0);
  for (int kt = 0; kt < nkt; ++kt) {
    __builtin_amdgcn_s_waitcnt(0x0070);
    __builtin_amdgcn_s_barrier();
    const char* base = smem + (kt & 1) * 24576;
    bf16x8 af[4][2], bf[2][2];
#pragma unroll
    for (int mt = 0; mt < 4; ++mt) { af[mt][0] = *(const bf16x8*)(base + aoff + mt * 2048 + p0); af[mt][1] = *(const bf16x8*)(base + aoff + mt * 2048 + p1); }
#pragma unroll
    for (int nt = 0; nt < 2; ++nt) { bf[nt][0] = *(const bf16x8*)(base + boff + nt * 2048 + p0); bf[nt][1] = *(const bf16x8*)(base + boff + nt * 2048 + p1); }
    __builtin_amdgcn_sched_barrier(0);
    if (kt + 1 < nkt) glds(kt + 1, (kt + 1) & 1);
    __builtin_amdgcn_sched_barrier(0);
#pragma unroll
    for (int ks = 0; ks < 2; ++ks)
#pragma unroll
      for (int mt = 0; mt < 4; ++mt) {
        if (NORM) ss[mt] = sumsq_frag(af[mt][ks], ss[mt]);
        acc[mt][0] = MFMA32(af[mt][ks], bf[0][ks], acc[mt][0]);
        acc[mt][1] = MFMA32(af[mt][ks], bf[1][ks], acc[mt][1]);
      }
  }
  if (NORM) {
#pragma unroll
    for (int mt = 0; mt < 4; ++mt) {
      ss[mt] += __shfl_xor(ss[mt], 32);
      if (wn == 0 && h == 0) rs[wm * 128 + mt * 32 + r] = rsqrtf(ss[mt] * inv_nk + EPSV);
    }
    __syncthreads();
  }
#pragma unroll
  for (int mt = 0; mt < 4; ++mt) epi(m0 + wm * 128 + mt * 32, n0 + wn * 64, acc[mt][0], acc[mt][1], rs + wm * 128 + mt * 32);
}

DI void conv_tile(char* smem, const float* __restrict__ src, int K, int N, const float* __restrict__ gain, bf16_t* __restrict__ dst, int tile, int ntn) {
  __syncthreads();
  const int tid = TIDX();
  const int kt = tile / ntn, nt = tile - kt * ntn, k0 = kt * 64, n0 = nt * 64;
  float* t = (float*)smem;
  float cv[16];
#pragma unroll
  for (int it = 0; it < 16; ++it) {
    const int e = tid + 256 * it, kk = e >> 6, nn = e & 63, n = n0 + nn;
    cv[it] = (n < N) ? __builtin_nontemporal_load(&src[(size_t)(k0 + kk) * N + n]) : 0.f;
  }
  float gv[16];
  if (gain) {
#pragma unroll
    for (int it = 0; it < 16; ++it) gv[it] = gain[k0 + ((tid + 256 * it) >> 6)];
  } else {
#pragma unroll
    for (int it = 0; it < 16; ++it) gv[it] = 1.f;
  }
#pragma unroll
  for (int it = 0; it < 16; ++it) {
    const int e = tid + 256 * it, kk = e >> 6, nn = e & 63;
    t[kk * 65 + nn] = cv[it] * gv[it];
  }
  __syncthreads();
#pragma unroll
  for (int it = 0; it < 2; ++it) {
    const int e = tid + 256 * it, nn = e >> 3, ko = (e & 7) * 8;
    uint4 o;
    o.x = pack2(t[(ko + 0) * 65 + nn], t[(ko + 1) * 65 + nn]);
    o.y = pack2(t[(ko + 2) * 65 + nn], t[(ko + 3) * 65 + nn]);
    o.z = pack2(t[(ko + 4) * 65 + nn], t[(ko + 5) * 65 + nn]);
    o.w = pack2(t[(ko + 6) * 65 + nn], t[(ko + 7) * 65 + nn]);
    *(uint4*)(dst + (size_t)(n0 + nn) * K + k0 + ko) = o;
  }
}

constexpr int CONV_MLP_ITEMS = 2048;
DI void conv_mlp_item(const Params& p, char* smem, int l, int item) {
  bf16_t* w1t = (bf16_t*)(p.ws + OFF_WMLP);
  bf16_t* w2t = (bf16_t*)(p.ws + OFF_WMLP + 8 * MiB);
  if (item < 1024) conv_tile(smem, p.in[21] + (size_t)l * 1024 * 4096, 1024, 4096, p.in[20] + l * 1024, w1t, item, 64);
  else conv_tile(smem, p.in[22] + (size_t)l * 4096 * 1024, 4096, 1024, nullptr, w2t, item - 1024, 16);
}
DI int conv_mix_count(int l) { return (l & 1) ? 800 : 736; }
DI void conv_mix_item(const Params& p, char* smem, int l, int item) {
  const int j = l >> 1;
  char* wm = p.ws + OFF_WMIX;
  if (l & 1) {
    if (item < 544) conv_tile(smem, p.in[17] + (size_t)j * 1024 * 2120, 1024, 2120, p.in[16] + j * 1024, (bf16_t*)wm, item, 34);
    else conv_tile(smem, p.in[19] + (size_t)j * 1024 * 1024, 1024, 1024, nullptr, (bf16_t*)(wm + 4 * MiB + 512 * 1024), item - 544, 16);
  } else {
    if (item < 384) conv_tile(smem, p.in[3] + (size_t)j * 1024 * 1440, 1024, 1440, p.in[2] + j * 1024, (bf16_t*)wm, item, 24);
    else if (item < 432) conv_tile(smem, p.in[12] + (size_t)j * 256 * 768, 256, 768, p.in[11] + j * 256, (bf16_t*)(wm + 3 * MiB), item - 384, 12);
    else if (item < 464) conv_tile(smem, p.in[14] + (size_t)j * 128 * 1024, 128, 1024, p.in[13] + j * 128, (bf16_t*)(wm + 3 * MiB + 512 * 1024), item - 432, 16);
    else if (item < 720) conv_tile(smem, p.in[15] + (size_t)j * 1024 * 1024, 1024, 1024, nullptr, (bf16_t*)(wm + 4 * MiB), item - 464, 16);
    else if (item < 728) { const int n = item - 720; conv_tile(smem, p.in[6] + ((size_t)j * 8 + n) * 4096, 64, 64, nullptr, (bf16_t*)(wm + 6 * MiB) + n * 4096, 0, 1); }
    else { const int n = item - 728; conv_tile(smem, p.in[8] + ((size_t)j * 8 + n) * 4096, 64, 64, nullptr, (bf16_t*)(wm + 6 * MiB + 65536) + n * 4096, 0, 1); }
  }
}

template <int DQK>
struct QTile { bf16x8 qf[DQK / 16]; f32x16 o0, o1; float m, l; };

template <int DQK>
DI void attn_qt_init(QTile<DQK>& q, const bf16_t* __restrict__ Qrow, int h) {
#pragma unroll
  for (int ks = 0; ks < DQK / 16; ++ks) q.qf[ks] = *(const bf16x8*)(Qrow + ks * 16 + h * 8);
  q.o0 = zero16(); q.o1 = zero16(); q.m = -1e30f; q.l = 0.f;
}

template <int DQK, bool MASK>
DI void attn_qt_step(QTile<DQK>& q, const bf16_t* Ks, const bf16_t* Vs, unsigned mw0, unsigned mw1, int r, int h) {
  constexpr int KST = DQK + 8;
  constexpr int NKS = DQK / 16;
  f32x16 st0 = zero16(), st1 = zero16();
#pragma unroll
  for (int ks = 0; ks < NKS; ++ks) {
    const bf16x8 a0 = *(const bf16x8*)(Ks + r * KST + ks * 16 + h * 8);
    const bf16x8 a1 = *(const bf16x8*)(Ks + (32 + r) * KST + ks * 16 + h * 8);
    st0 = MFMA32(a0, q.qf[ks], st0);
    st1 = MFMA32(a1, q.qf[ks], st1);
  }
  float mx = -1e30f;
#pragma unroll
  for (int i = 0; i < 16; ++i) {
    const int cr = CROW(i, h);
    if (!MASK || ((mw0 >> cr) & 1u)) mx = fmaxf(mx, st0[i]);
    if (!MASK || ((mw1 >> cr) & 1u)) mx = fmaxf(mx, st1[i]);
  }
  mx = fmaxf(mx, __shfl_xor(mx, 32));
  const float mnew = fmaxf(q.m, mx);
  const float alpha = __builtin_amdgcn_exp2f(q.m - mnew);
  q.m = mnew;
  float ps = 0.f;
#pragma unroll
  for (int i = 0; i < 16; ++i) {
    const int cr = CROW(i, h);
    const float p0 = (!MASK || ((mw0 >> cr) & 1u)) ? __builtin_amdgcn_exp2f(st0[i] - mnew) : 0.f;
    const float p1 = (!MASK || ((mw1 >> cr) & 1u)) ? __builtin_amdgcn_exp2f(st1[i] - mnew) : 0.f;
    st0[i] = p0; st1[i] = p1; ps += p0 + p1;
  }
  q.l = q.l * alpha + ps;
#pragma unroll
  for (int i = 0; i < 16; ++i) { q.o0[i] *= alpha; q.o1[i] *= alpha; }
#pragma unroll
  for (int s2 = 0; s2 < 2; ++s2) {
    uint4 pk0, pk1;
    pk0.x = pack2(st0[8 * s2 + 0], st0[8 * s2 + 1]); pk0.y = pack2(st0[8 * s2 + 2], st0[8 * s2 + 3]);
    pk0.z = pack2(st0[8 * s2 + 4], st0[8 * s2 + 5]); pk0.w = pack2(st0[8 * s2 + 6], st0[8 * s2 + 7]);
    pk1.x = pack2(st1[8 * s2 + 0], st1[8 * s2 + 1]); pk1.y = pack2(st1[8 * s2 + 2], st1[8 * s2 + 3]);
    pk1.z = pack2(st1[8 * s2 + 4], st1[8 * s2 + 5]); pk1.w = pack2(st1[8 * s2 + 6], st1[8 * s2 + 7]);
    const bf16x8 pf0 = __builtin_bit_cast(bf16x8, pk0), pf1 = __builtin_bit_cast(bf16x8, pk1);
    {
      const bf16_t* vp = Vs + r * 68 + 16 * s2 + 4 * h;
      const uint2 lo = *(const uint2*)vp, hi = *(const uint2*)(vp + 8);
      const uint2 lo2 = *(const uint2*)(vp + 32 * 68), hi2 = *(const uint2*)(vp + 32 * 68 + 8);
      q.o0 = MFMA32(__builtin_bit_cast(bf16x8, make_uint4(lo.x, lo.y, hi.x, hi.y)), pf0, q.o0);
      q.o1 = MFMA32(__builtin_bit_cast(bf16x8, make_uint4(lo2.x, lo2.y, hi2.x, hi2.y)), pf0, q.o1);
    }
    {
      const bf16_t* vp = Vs + r * 68 + 32 + 16 * s2 + 4 * h;
      const uint2 lo = *(const uint2*)vp, hi = *(const uint2*)(vp + 8);
      const uint2 lo2 = *(const uint2*)(vp + 32 * 68), hi2 = *(const uint2*)(vp + 32 * 68 + 8);
      q.o0 = MFMA32(__builtin_bit_cast(bf16x8, make_uint4(lo.x, lo.y, hi.x, hi.y)), pf1, q.o0);
      q.o1 = MFMA32(__builtin_bit_cast(bf16x8, make_uint4(lo2.x, lo2.y, hi2.x, hi2.y)), pf1, q.o1);
    }
  }
}

template <int DQK>
DI void attn_qt_store(QTile<DQK>& q, bf16_t* __restrict__ orow, int h) {
  const float lt = q.l + __shfl_xor(q.l, 32);
  const float inv = 1.f / lt;
#pragma unroll
  for (int g4 = 0; g4 < 4; ++g4) {
    const int d0 = 8 * g4 + 4 * h;
    uint2 v;
    v.x = pack2(q.o0[4 * g4 + 0] * inv, q.o0[4 * g4 + 1] * inv); v.y = pack2(q.o0[4 * g4 + 2] * inv, q.o0[4 * g4 + 3] * inv);
    *(uint2*)(orow + d0) = v;
    v.x = pack2(q.o1[4 * g4 + 0] * inv, q.o1[4 * g4 + 1] * inv); v.y = pack2(q.o1[4 * g4 + 2] * inv, q.o1[4 * g4 + 3] * inv);
    *(uint2*)(orow + 32 + d0) = v;
  }
}

template <int DQK, int NQT, bool MASK>
DI void attn_core(char* smem, const bf16_t* __restrict__ Kg, const bf16_t* __restrict__ Vtg, const bf16_t* __restrict__ Qw,
                  int nch_blk, int nch_wave, bf16_t* __restrict__ outp, int ostride) {
  constexpr int KST = DQK + 8;
  constexpr int C8 = DQK / 8;
  bf16_t* Ks = (bf16_t*)smem;
  bf16_t* Vs = (bf16_t*)(smem + 13312);
  const unsigned* maskl = (const unsigned*)(smem + 22016);
  const int tid = TIDX(), lane = tid & 63, r = lane & 31, h = lane >> 5;
  QTile<DQK> q0, q1;
  attn_qt_init<DQK>(q0, Qw + (size_t)r * DQK, h);
  if (NQT > 1) attn_qt_init<DQK>(q1, Qw + (size_t)(32 + r) * DQK, h);
  uint4 kr0, kr1, kr2, vr0, vr1;
  const int vd0 = tid >> 3, vc8 = tid & 7;
#define ATTN_GLOAD(kc_)                                                                          \
  {                                                                                              \
    const uint4* kp_ = (const uint4*)(Kg + (size_t)(kc_) * 64 * DQK);                            \
    kr0 = kp_[tid]; kr1 = kp_[tid + 256];                                                        \
    if (DQK == 96) kr2 = kp_[tid + 512];                                                         \
    vr0 = *(const uint4*)(Vtg + (size_t)vd0 * S + (kc_) * 64 + vc8 * 8);                         \
    vr1 = *(const uint4*)(Vtg + (size_t)(vd0 + 32) * S + (kc_) * 64 + vc8 * 8);                  \
  }
  ATTN_GLOAD(0);
  for (int kc = 0; kc < nch_blk; ++kc) {
    __syncthreads();
    {
      { const int e = tid, row = e / C8, c8 = e - row * C8; *(uint4*)(Ks + row * KST + c8 * 8) = kr0; }
      { const int e = tid + 256, row = e / C8, c8 = e - row * C8; *(uint4*)(Ks + row * KST + c8 * 8) = kr1; }
      if (DQK == 96) { const int e = tid + 512, row = e / C8, c8 = e - row * C8; *(uint4*)(Ks + row * KST + c8 * 8) = kr2; }
      uint2* vp = (uint2*)(Vs + vd0 * 68 + vc8 * 8);
      vp[0] = make_uint2(vr0.x, vr0.y); vp[1] = make_uint2(vr0.z, vr0.w);
      vp = (uint2*)(Vs + (vd0 + 32) * 68 + vc8 * 8);
      vp[0] = make_uint2(vr1.x, vr1.y); vp[1] = make_uint2(vr1.z, vr1.w);
    }
    __syncthreads();
    if (kc + 1 < nch_blk) ATTN_GLOAD(kc + 1);
    if (kc < nch_wave) {
      unsigned mw0 = 0xffffffffu, mw1 = 0xffffffffu;
      if (MASK) { mw0 = maskl[r * 65 + 2 * kc]; mw1 = maskl[r * 65 + 2 * kc + 1]; }
      attn_qt_step<DQK, MASK>(q0, Ks, Vs, mw0, mw1, r, h);
      if (NQT > 1) {
        __builtin_amdgcn_sched_barrier(0);
        mw0 = 0xffffffffu; mw1 = 0xffffffffu;
        if (MASK) { mw0 = maskl[(32 + r) * 65 + 2 * kc]; mw1 = maskl[(32 + r) * 65 + 2 * kc + 1]; }
        attn_qt_step<DQK, MASK>(q1, Ks, Vs, mw0, mw1, r, h);
      }
    }
  }
#undef ATTN_GLOAD
  attn_qt_store<DQK>(q0, outp + (size_t)r * ostride, h);
  if (NQT > 1) attn_qt_store<DQK>(q1, outp + (size_t)(32 + r) * ostride, h);
}

DI void lru1_item(const Params& p, char* smem, int j, int item) {
  __syncthreads();
  const int n = item & 7, ch = (item >> 3) & 31, b = item >> 8;
  const int t0 = b * S + ch * 64, c0 = n * 64;
  char* R = p.ws + OFF_R;
  const bf16_t* xr = (const bf16_t*)(R);
  bf16_t* Pg = (bf16_t*)(R + 84 * MiB);
  bf16_t* hl = (bf16_t*)(R + 100 * MiB);
  float* Asum = (float*)(p.ws + OFF_MISC + 2 * MiB);
  float* Bsum = (float*)(p.ws + OFF_MISC + 2 * MiB + 512 * 1024);
  const bf16_t* gaT = (const bf16_t*)(p.ws + OFF_WMIX + 6 * MiB) + n * 4096;
  const bf16_t* gxT = (const bf16_t*)(p.ws + OFF_WMIX + 6 * MiB + 65536) + n * 4096;
  const float* conv_w = p.in[4] + j * 4 * 512;
  const float* conv_b = p.in[5] + j * 512;
  const float* ga_b = p.in[7] + j * 512;
  const float* gx_b = p.in[9] + j * 512;
  const float* lam = p.in[10] + j * 512;
  bf16_t* xcb = (bf16_t*)smem;
  float* av = (float*)(smem + 9216);
  float* bv = (float*)(smem + 25600);
  const int tid = TIDX(), lane = tid & 63, w = tid >> 6, r = lane & 31, h = lane >> 5;
  {
    const int cp = tid & 31, c = c0 + 2 * cp, tb = tid >> 5;
    float2 wq[4];
#pragma unroll
    for (int q = 0; q < 4; ++q) wq[q] = *(const float2*)(conv_w + q * 512 + c);
    const float2 bb = *(const float2*)(conv_b + c);
    unsigned xv[8][4];
#pragma unroll
    for (int it = 0; it < 8; ++it)
#pragma unroll
      for (int q = 0; q < 4; ++q) {
        const int t = tb + 8 * it, sl = ch * 64 + t - 3 + q;
        const int row = (sl >= 0) ? (t0 + t - 3 + q) : t0;
        xv[it][q] = *(const unsigned*)(xr + (size_t)row * 512 + c);
      }
#pragma unroll
    for (int it = 0; it < 8; ++it) {
      const int t = tb + 8 * it;
      float x0 = bb.x, x1 = bb.y;
#pragma unroll
      for (int q = 0; q < 4; ++q) {
        const int sl = ch * 64 + t - 3 + q;
        const unsigned v = (sl >= 0) ? xv[it][q] : 0u;
        x0 += lo2f(v) * wq[q].x; x1 += hi2f(v) * wq[q].y;
      }
      *(float2*)(bv + t * 64 + 2 * cp) = make_float2(x0, x1);
      *(unsigned*)(xcb + t * 72 + 2 * cp) = pack2(x0, x1);
    }
  }
  const int gchan = c0 + 32 * (w & 1) + r;
  const float g_lam = lam[gchan], g_gab = ga_b[gchan], g_gxb = gx_b[gchan];
  __syncthreads();
  {
    const int mt = w >> 1, nt = w & 1;
    f32x16 ga = zero16(), gx = zero16();
#pragma unroll
    for (int ks = 0; ks < 4; ++ks) {
      const bf16x8 a = *(const bf16x8*)(xcb + (32 * mt + r) * 72 + 16 * ks + 8 * h);
      const bf16x8 ba = *(const bf16x8*)(gaT + (32 * nt + r) * 64 + 16 * ks + 8 * h);
      const bf16x8 bx = *(const bf16x8*)(gxT + (32 * nt + r) * 64 + 16 * ks + 8 * h);
      ga = MFMA32(a, ba, ga); gx = MFMA32(a, bx, gx);
    }
    const int c = 32 * nt + r, chan = c0 + c;
    const float el = __expf(-g_lam);
    const float sp = (el < 0.02f) ? el * (1.f - el * (0.5f - el * (0.33333334f - 0.25f * el))) : __logf(1.f + el);
    const float la = -8.f * sp;
    const float gab = g_gab, gxb = g_gxb;
#pragma unroll
    for (int i = 0; i < 16; ++i) {
      const int t = 32 * mt + CROW(i, h);
      const float rg = sigmoidf_(ga[i] + gab), ig = sigmoidf_(gx[i] + gxb);
      const float log_a = la * rg;
      const float a = __expf(log_a);
      const float mult = sqrtf(fmaxf(1.f - a * a, 0.f));
      const float xcv = bv[t * 64 + c];
      av[t * 64 + c] = a;
      bv[t * 64 + c] = mult * ig * xcv;
    }
  }
  __syncthreads();
  {
    const int c = tid & 63, q = tid >> 6;
    float A = 1.f, H = 0.f;
    const int tend = 16 * q + 16;
#pragma unroll 4
    for (int t = 0; t < tend; ++t) {
      const float a = av[t * 64 + c];
      H = a * H + bv[t * 64 + c];
      A *= a;
      if (t >= 16 * q) {
        hl[(size_t)(t0 + t) * 512 + c0 + c] = f2bf(H);
        Pg[(size_t)(t0 + t) * 512 + c0 + c] = f2bf(A);
      }
    }
    if (q == 3) { Asum[(b * 32 + ch) * 512 + c0 + c] = A; Bsum[(b * 32 + ch) * 512 + c0 + c] = H; }
  }
}

DI void lru2_item(const Params& p, char* smem, int item) {
  __syncthreads();
  const int ch = item & 31, b = item >> 5;
  char* R = p.ws + OFF_R;
  const bf16_t* gg = (const bf16_t*)(R + 16 * MiB);
  const bf16_t* Pg = (const bf16_t*)(R + 84 * MiB);
  bf16_t* hl = (bf16_t*)(R + 100 * MiB);
  const float* Asum = (const float*)(p.ws + OFF_MISC + 2 * MiB);
  const float* Bsum = (const float*)(p.ws + OFF_MISC + 2 * MiB + 512 * 1024);
  float* carry = (float*)smem;
  const int tid = TIDX();
#pragma unroll
  for (int k = 0; k < 2; ++k) {
    const int c = tid + 256 * k;
    float H = 0.f;
    for (int q0 = 0; q0 < ch; q0 += 8) {
      float ca[8], cb2[8];
#pragma unroll
      for (int u = 0; u < 8; ++u) { const int q = (q0 + u < 32) ? (q0 + u) : 31; ca[u] = Asum[(b * 32 + q) * 512 + c]; cb2[u] = Bsum[(b * 32 + q) * 512 + c]; }
#pragma unroll
      for (int u = 0; u < 8; ++u) { const bool on = (q0 + u) < ch; H = (on ? ca[u] : 1.f) * H + (on ? cb2[u] : 0.f); }
    }
    carry[c] = H;
  }
  __syncthreads();
  const size_t base = (size_t)(b * S + ch * 64) * 512;
#pragma unroll 1
  for (int it0 = 0; it0 < 64; it0 += 16) {
    unsigned hv[16], pv[16], gv[16];
#pragma unroll
    for (int u = 0; u < 16; ++u) {
      const int e = tid + 256 * (it0 + u);
      const size_t off = base + (size_t)(e >> 8) * 512 + 2 * (e & 255);
      hv[u] = *(const unsigned*)(hl + off); pv[u] = *(const unsigned*)(Pg + off); gv[u] = *(const unsigned*)(gg + off);
    }
#pragma unroll
    for (int u = 0; u < 16; ++u) {
      const int e = tid + 256 * (it0 + u);
      const int c = 2 * (e & 255);
      const size_t off = base + (size_t)(e >> 8) * 512 + c;
      const float y0 = (lo2f(hv[u]) + lo2f(pv[u]) * carry[c]) * lo2f(gv[u]);
      const float y1 = (hi2f(hv[u]) + hi2f(pv[u]) * carry[c + 1]) * hi2f(gv[u]);
      *(unsigned*)(hl + off) = pack2(y0, y1);
    }
  }
}

DI unsigned tokey(float f) { unsigned u = __float_as_uint(f + 0.0f); return (u & 0x80000000u) ? ~u : (u | 0x80000000u); }

DI int tk_cnt(const int* hist, int hq, int bin) {
  return hist[(0 * 16 + hq) * 256 + bin] + hist[(1 * 16 + hq) * 256 + bin] + hist[(2 * 16 + hq) * 256 + bin] + hist[(3 * 16 + hq) * 256 + bin];
}
DI void tk_scan(const int* hist, int* res, int hq, int hl, int K) {
  int psum = 0;
#pragma unroll
  for (int x = 0; x < 16; ++x) psum += tk_cnt(hist, hq, 16 * hl + x);
  int inc = psum;
#pragma unroll
  for (int d = 1; d < 16; d <<= 1) { const int t = __shfl_up(inc, d, 16); if (hl >= d) inc += t; }
  const int e = inc - psum;
  if (e < K && K <= inc) {
    int run = e, found = 0, fb = 0, fk = 0, fc = 0;
    for (int x = 0; x < 16; ++x) {
      const int cnt = tk_cnt(hist, hq, 16 * hl + x);
      if (!found && K <= run + cnt) { found = 1; fb = 16 * hl + x; fk = K - run; fc = cnt; }
      run += cnt;
    }
    res[hq * 4 + 0] = fb; res[hq * 4 + 1] = fk; res[hq * 4 + 2] = fc;
  }
}

DI void topk_item(const Params& p, char* smem, int item) {
  __syncthreads();
  const int qq = item & 3, rest = item >> 2, b = rest & 7, c = 31 - (rest >> 3);
  const int q0 = c * 64 + qq * 16;
  const int ntw = c + 1;
  char* R = p.ws + OFF_R;
  const bf16_t* qi = (const bf16_t*)(R + 48 * MiB);
  const bf16_t* kib = (const bf16_t*)(R + 64 * MiB);
  unsigned* sel = (unsigned*)(R + 66 * MiB);
  const float* wif = (const float*)(p.ws + OFF_MISC + 3 * MiB);
  const int blk = blockIdx.x;
  unsigned* scr = (unsigned*)((blk < 256) ? (p.ws + OFF_X + (size_t)blk * 131072) : (R + 70 * MiB + (size_t)(blk - 256) * 131072));
  int* hist = (int*)smem;
  bf16_t* qs = (bf16_t*)(smem + 16384);
  int* res = (int*)(smem + 65600);
  const int tid = TIDX(), lane = tid & 63, w = tid >> 6, qn = lane & 15, g = lane >> 4;
#pragma unroll
  for (int it = 0; it < 4; ++it) {
    const int e = tid + 256 * it, hd = e >> 7, rem = e & 127, q = rem >> 3, c8 = rem & 7;
    const uint4 v = *(const uint4*)(qi + ((size_t)(b * 8 + hd) * S + q0 + q) * 64 + c8 * 8);
    *(uint4*)(qs + (hd * 16 + q) * 72 + c8 * 8) = v;
  }
  __syncthreads();
  {
    float wq0, wq1, wq2, wq3, wq4, wq5, wq6, wq7;
    const float4* wp = (const float4*)(wif + (size_t)(b * S + q0 + qn) * 8);
    const float4 wa = wp[0], wb = wp[1];
    wq0 = wa.x; wq1 = wa.y; wq2 = wa.z; wq3 = wa.w; wq4 = wb.x; wq5 = wb.y; wq6 = wb.z; wq7 = wb.w;
    const bf16_t* qsl = qs + qn * 72 + 8 * g;
#define TK_HEAD(hd_, wq_)                                                                         \
  {                                                                                               \
    const bf16x8 f0_ = *(const bf16x8*)(qsl + (hd_) * 16 * 72), f1_ = *(const bf16x8*)(qsl + (hd_) * 16 * 72 + 32); \
    f32x4 s_ = MFMA16(a0, f0_, z);                                                                \
    s_ = MFMA16(a1, f1_, s_);                                                                     \
    acc0 += (wq_) * fmaxf(s_[0], 0.f); acc1 += (wq_) * fmaxf(s_[1], 0.f);                         \
    acc2 += (wq_) * fmaxf(s_[2], 0.f); acc3 += (wq_) * fmaxf(s_[3], 0.f);                         \
  }
#pragma unroll 1
    for (int jt0 = 0; jt0 < ntw; jt0 += 4) {
      bf16x8 ka0[4], ka1[4];
#pragma unroll
      for (int u = 0; u < 4; ++u) {
        const int jt = (jt0 + u < ntw) ? (jt0 + u) : (ntw - 1);
        const bf16_t* kp = kib + (size_t)(b * S + 16 * (w + 4 * jt) + qn) * 64 + 8 * g;
        ka0[u] = *(const bf16x8*)kp; ka1[u] = *(const bf16x8*)(kp + 32);
      }
#pragma unroll
      for (int u = 0; u < 4; ++u) {
        if (jt0 + u < ntw) {
          const int kt = w + 4 * (jt0 + u);
          const bf16x8 a0 = ka0[u], a1 = ka1[u];
          const f32x4 z = {0.f, 0.f, 0.f, 0.f};
          float acc0 = 0.f, acc1 = 0.f, acc2 = 0.f, acc3 = 0.f;
          TK_HEAD(0, wq0) TK_HEAD(1, wq1) TK_HEAD(2, wq2) TK_HEAD(3, wq3)
          TK_HEAD(4, wq4) TK_HEAD(5, wq5) TK_HEAD(6, wq6) TK_HEAD(7, wq7)
          uint4 o; o.x = tokey(acc0); o.y = tokey(acc1); o.z = tokey(acc2); o.w = tokey(acc3);
          *(uint4*)(scr + qn * 2048 + 16 * kt + 4 * g) = o;
        }
      }
    }
#undef TK_HEAD
  }
  __syncthreads();
  const int hq = tid >> 4, hl = tid & 15;
  const unsigned* srow = scr + hq * 2048 + 4 * hl;
  uint4 kv[32];
#pragma unroll
  for (int j = 0; j < 32; ++j) kv[j] = (j < ntw) ? *(const uint4*)(srow + 64 * j) : make_uint4(0u, 0u, 0u, 0u);
  int* hcp = hist + ((hl & 3) * 16 + hq) * 256;
#define TK_ZERO_HIST() { _Pragma("unroll") for (int it = 0; it < 16; ++it) ((uint4*)hist)[tid + 256 * it] = make_uint4(0u, 0u, 0u, 0u); }
#define TK_FOREACH(BODY)                                                                   \
  _Pragma("unroll") for (int j = 0; j < 32; ++j) {                                         \
    if (j < ntw) {                                                                         \
      const unsigned uu_[4] = {kv[j].x, kv[j].y, kv[j].z, kv[j].w};                        \
      _Pragma("unroll") for (int e = 0; e < 4; ++e) { const unsigned u = uu_[e]; const int idx = 64 * j + 4 * hl + e; (void)idx; BODY }  \
    }                                                                                      \
  }
  unsigned prefix = 0;
  int Krem = 256, ceq = 0;
#pragma unroll 1
  for (int pass = 0; pass < 4; ++pass) {
    const int shift = 24 - 8 * pass;
    __syncthreads();
    TK_ZERO_HIST();
    __syncthreads();
    const unsigned pmask = (pass == 0) ? 0u : (0xffffffffu << (shift + 8));
    const unsigned pval = prefix << ((shift + 8) & 31);
    TK_FOREACH( if ((u & pmask) == (pval & pmask)) atomicAdd(&hcp[255 - ((u >> shift) & 255u)], 1); )
    __syncthreads();
    tk_scan(hist, res, hq, hl, Krem);
    __syncthreads();
    prefix = (prefix << 8) | (unsigned)(255 - res[hq * 4 + 0]);
    Krem = res[hq * 4 + 1];
    ceq = res[hq * 4 + 2];
  }
  const unsigned Tq = prefix;
  const int need = Krem;
  int Jlast = 4095;
  if (__syncthreads_or(ceq != need)) {
    TK_ZERO_HIST();
    __syncthreads();
    TK_FOREACH( if (u == Tq) atomicAdd(&hcp[idx >> 3], 1); )
    __syncthreads();
    tk_scan(hist, res, hq, hl, need);
    __syncthreads();
    const int binB = res[hq * 4 + 0], k2 = res[hq * 4 + 1];
    __syncthreads();
    TK_ZERO_HIST();
    __syncthreads();
    TK_FOREACH( if (u == Tq && (idx >> 3) == binB) atomicAdd(&hcp[idx & 7], 1); )
    __syncthreads();
    tk_scan(hist, res, hq, hl, k2);
    __syncthreads();
    Jlast = binB * 8 + res[hq * 4 + 0];
  }
#pragma unroll
  for (int j = 0; j < 32; ++j) {
    if (j < ntw) {
      const unsigned uu_[4] = {kv[j].x, kv[j].y, kv[j].z, kv[j].w};
      unsigned word = 0;
#pragma unroll
      for (int e = 0; e < 4; ++e) {
        const int idx = 64 * j + 4 * hl + e;
        const bool sl = (uu_[e] > Tq) || (uu_[e] == Tq && idx <= Jlast);
        word |= sl ? (1u << ((hl & 7) * 4 + e)) : 0u;
      }
      word |= __shfl_xor(word, 1); word |= __shfl_xor(word, 2); word |= __shfl_xor(word, 4);
      if ((hl & 7) == 0) sel[(size_t)(b * S + q0 + hq) * 64 + 2 * j + (hl >> 3)] = word;
    }
  }
#undef TK_FOREACH
#undef TK_ZERO_HIST
}

DI void phase_prologue(const Params& p, char* smem) {
  const int nb = gridDim.x, bid = blockIdx.x, tid = TIDX();
  const float* x = p.in[0];
  bf16_t* xb = (bf16_t*)(p.ws + OFF_XB);
  float* cs = (float*)(p.ws + OFF_MISC);
  const int n_xb = T * 1024 / 8192, n_cs = T * 16 / 256, n_cv = conv_mix_count(0);
  for (int it = bid; it < n_xb + n_cs + n_cv; it += nb) {
    if (it < n_xb) {
      float4 v0[4], v1[4];
#pragma unroll
      for (int u = 0; u < 4; ++u) { const size_t e = (size_t)it * 8192 + u * 2048 + tid * 8; { const f32x4 t0 = __builtin_nontemporal_load((const f32x4*)(x + e)), t1 = __builtin_nontemporal_load((const f32x4*)(x + e + 4)); v0[u] = make_float4(t0[0], t0[1], t0[2], t0[3]); v1[u] = make_float4(t1[0], t1[1], t1[2], t1[3]); } }
#pragma unroll
      for (int u = 0; u < 4; ++u) {
        const size_t e = (size_t)it * 8192 + u * 2048 + tid * 8;
        uint4 o; o.x = pack2(v0[u].x, v0[u].y); o.y = pack2(v0[u].z, v0[u].w); o.z = pack2(v1[u].x, v1[u].y); o.w = pack2(v1[u].z, v1[u].w);
        *(uint4*)(xb + e) = o;
      }
    } else if (it < n_xb + n_cs) {
      const int e = (it - n_xb) * 256 + tid, t = e >> 4, jf = e & 15;
      const float freq = __builtin_amdgcn_exp2f(-(float)jf * 0.8304820237218406f);
      const float ang = (float)p.pos[t] * freq;
      double rev = (double)ang * 0.15915494309189535;
      rev -= floor(rev);
      const float rf = (float)rev;
      cs[t * 32 + jf] = __builtin_amdgcn_cosf(rf);
      cs[t * 32 + 16 + jf] = __builtin_amdgcn_sinf(rf);
    } else {
      conv_mix_item(p, smem, 0, it - n_xb - n_cs);
    }
  }
}

DI void phase_final(const Params& p) {
  const float* x = (const float*)(p.ws + OFF_X);
  const float* g = p.in[23];
  const int lane = TIDX() & 63, w = TIDX() >> 6;
  float4 gv[4];
#pragma unroll
  for (int q = 0; q < 4; ++q) gv[q] = *(const float4*)(g + (lane + 64 * q) * 4);
  for (int row0 = (blockIdx.x * 4 + w) * 4; row0 < T; row0 += gridDim.x * 16) {
    float4 v[4][4];
#pragma unroll
    for (int rr = 0; rr < 4; ++rr)
#pragma unroll
      for (int q = 0; q < 4; ++q) v[rr][q] = *(const float4*)(x + (size_t)(row0 + rr) * 1024 + (lane + 64 * q) * 4);
#pragma unroll
    for (int rr = 0; rr < 4; ++rr) {
      float ss = 0.f;
#pragma unroll
      for (int q = 0; q < 4; ++q) ss += v[rr][q].x * v[rr][q].x + v[rr][q].y * v[rr][q].y + v[rr][q].z * v[rr][q].z + v[rr][q].w * v[rr][q].w;
#pragma unroll
      for (int o = 1; o < 64; o <<= 1) ss += __shfl_xor(ss, o);
      const float rstd = rsqrtf(ss * (1.f / 1024.f) + EPSV);
#pragma unroll
      for (int q = 0; q < 4; ++q) {
        float4 o; o.x = v[rr][q].x * rstd * gv[q].x; o.y = v[rr][q].y * rstd * gv[q].y; o.z = v[rr][q].z * rstd * gv[q].z; o.w = v[rr][q].w * rstd * gv[q].w;
        { const f32x4 ov = {o.x, o.y, o.z, o.w}; __builtin_nontemporal_store(ov, (f32x4*)(p.out + (size_t)(row0 + rr) * 1024 + (lane + 64 * q) * 4)); }
      }
    }
  }
}

struct EpiResid {
  const float* xin;
  float* xout;
  bf16_t* xb;
  DI void operator()(int rb, int cb, const f32x16& c0, const f32x16& c1, const float*) const {
    const int lane = TIDX() & 63, r = lane & 31, h = lane >> 5;
    bf16_t r0[16], r1[16];
#pragma unroll
    for (int i = 0; i < 16; ++i) { const size_t o = (size_t)(rb + CROW(i, h)) * 1024 + cb + r; r0[i] = xb[o]; r1[i] = xb[o + 32]; }
    __builtin_amdgcn_sched_barrier(0);
    float x0[16], x1[16];
#pragma unroll
    for (int i = 0; i < 16; ++i) { x0[i] = bf2f(r0[i]); x1[i] = bf2f(r1[i]); }
#pragma unroll
    for (int i = 0; i < 16; ++i) {
      const size_t o = (size_t)(rb + CROW(i, h)) * 1024 + cb + r;
      const float v0 = x0[i] + c0[i], v1 = x1[i] + c1[i];
      if (xout) { xout[o] = v0; xout[o + 32] = v1; }
      xb[o] = f2bf(v0); xb[o + 32] = f2bf(v1);
    }
  }
};

DI void phase_resid_gemm(const Params& p, char* smem, const bf16_t* a0, int lda0, const bf16_t* a1, int lda1, int ksplit,
                         const bf16_t* Wt, int K, const float* xin, bool write_f32) {
  EpiResid epi{xin, write_f32 ? (float*)(p.ws + OFF_X) : nullptr, (bf16_t*)(p.ws + OFF_XB)};
  if (ksplit >= K) {
    for (int it = blockIdx.x; it < 512; it += gridDim.x) {
      const int nt = (it >> 3) & 7, mt = ((it >> 6) << 3) | (it & 7);
      gemm_tile_big<false>(smem, a0, lda0, Wt, K, mt * 256, nt * 128, 0.f, epi);
    }
  } else {
    for (int it = blockIdx.x; it < 512; it += gridDim.x) {
      const int nt = (it >> 3) & 7, mt = ((it >> 6) << 3) | (it & 7);
      gemm_tile_big<false>(smem, a0, lda0, Wt, K, mt * 256, nt * 128, 0.f, epi, a1, ksplit);
    }
  }
}

DI void phase_E1(const Params& p, char* smem, int l) {
  char* R = p.ws + OFF_R;
  bf16_t* xr = (bf16_t*)R; bf16_t* gg = (bf16_t*)(R + 16 * MiB); bf16_t* cqb = (bf16_t*)(R + 32 * MiB); bf16_t* ckvb = (bf16_t*)(R + 40 * MiB);
  bf16_t* Kb = (bf16_t*)(R + 44 * MiB);
  const float* cs = (const float*)(p.ws + OFF_MISC);
  const bf16_t* xb = (const bf16_t*)(p.ws + OFF_XB);
  const bf16_t* Wt = (const bf16_t*)(p.ws + OFF_WMIX);
  auto epi = [=](int rb, int cb, const f32x16& c0, const f32x16& c1, const float* rsp) __attribute__((always_inline)) {
    const int lane = TIDX() & 63, r = lane & 31, h = lane >> 5;
    if (cb < 512) {
#pragma unroll
      for (int i = 0; i < 16; ++i) { const int cr = CROW(i, h); const float s = rsp[cr]; const size_t o = (size_t)(rb + cr) * 512 + cb + r; xr[o] = f2bf(c0[i] * s); xr[o + 32] = f2bf(c1[i] * s); }
    } else if (cb < 1024) {
#pragma unroll
      for (int i = 0; i < 16; ++i) { const int cr = CROW(i, h); const float s = rsp[cr]; const size_t o = (size_t)(rb + cr) * 512 + (cb - 512) + r; gg[o] = f2bf(gelu_tanh(c0[i] * s)); gg[o + 32] = f2bf(gelu_tanh(c1[i] * s)); }
    } else if (cb < 1280) {
#pragma unroll
      for (int i = 0; i < 16; ++i) { const int cr = CROW(i, h); const float s = rsp[cr]; const size_t o = (size_t)(rb + cr) * 256 + (cb - 1024) + r; cqb[o] = f2bf(c0[i] * s); cqb[o + 32] = f2bf(c1[i] * s); }
    } else if (cb < 1408) {
#pragma unroll
      for (int i = 0; i < 16; ++i) { const int cr = CROW(i, h); const float s = rsp[cr]; const size_t o = (size_t)(rb + cr) * 128 + (cb - 1280) + r; ckvb[o] = f2bf(c0[i] * s); ckvb[o + 32] = f2bf(c1[i] * s); }
    } else if (cb == 1408) {
      float ccv[16], snv[16];
#pragma unroll
      for (int i = 0; i < 16; ++i) { const int row = rb + CROW(i, h); ccv[i] = cs[row * 32 + (r & 15)]; snv[i] = cs[row * 32 + 16 + (r & 15)]; }
#pragma unroll
      for (int i = 0; i < 16; ++i) {
        const int cr = CROW(i, h); const int row = rb + cr;
        const float v = c0[i] * rsp[cr];
        const float pv = __shfl_xor(v, 16);
        const float cc = ccv[i], sn = snv[i];
        const float o = (r < 16) ? (v * cc - pv * sn) : (pv * sn + v * cc);
        const int b = row >> 11, s = row & 2047;
        const bf16_t ob = f2bf(o);
#pragma unroll
        for (int hd = 0; hd < 8; ++hd) Kb[((size_t)(b * 8 + hd) * S + s) * 96 + 64 + r] = ob;
      }
    }
  };
  const int ng = 1024;
  for (int it = blockIdx.x; it < ng; it += gridDim.x) {
    if (it < 512) { const int nt = (it >> 3) & 7, mt = ((it >> 6) << 3) | (it & 7); gemm_tile_big<true>(smem, xb, 1024, Wt, 1024, mt * 256, nt * 128, 1.f / 1024.f, epi); }
    else { const int i2 = it - 512; const int nt = 8 + (i2 >> 7), mt = i2 & 127; gemm_tile<true>(smem, xb, 1024, xb, 1024, 1 << 30, Wt, 1024, mt * 128, nt * 128, 1.f / 1024.f, epi); }
  }
}

DI void phase_E2(const Params& p, char* smem, int l) {
  char* R = p.ws + OFF_R;
  const bf16_t* cqb = (const bf16_t*)(R + 32 * MiB); const bf16_t* ckvb = (const bf16_t*)(R + 40 * MiB);
  bf16_t* Qb = (bf16_t*)(p.ws + OFF_X);
  bf16_t* Kb = (bf16_t*)(R + 44 * MiB); bf16_t* Vt = (bf16_t*)(R + 68 * MiB);
  const float* cs = (const float*)(p.ws + OFF_MISC);
  const bf16_t* WuqT = (const bf16_t*)(p.ws + OFF_WMIX + 3 * MiB);
  const bf16_t* WukvT = (const bf16_t*)(p.ws + OFF_WMIX + 3 * MiB + 512 * 1024);
  const float qscale = 0.10206207261596575f * LOG2E;
  auto epi_q = [=](int rb, int cb, const f32x16& c0, const f32x16& c1, const float* rsp) __attribute__((always_inline)) {
    const int lane = TIDX() & 63, r = lane & 31, h = lane >> 5;
#pragma unroll
    for (int ni = 0; ni < 2; ++ni) {
      const int col = cb + 32 * ni + r;
      const int hd = col / 96, dd = col - hd * 96;
      const bool rope = (((cb >> 5) + ni) % 3) == 2;
#pragma unroll
      for (int i0 = 0; i0 < 16; i0 += 8) {
      float ccv[8], snv[8];
      if (rope) {
#pragma unroll
        for (int i = 0; i < 8; ++i) { const int row = rb + CROW(i0 + i, h); ccv[i] = cs[row * 32 + (r & 15)]; snv[i] = cs[row * 32 + 16 + (r & 15)]; }
      }
#pragma unroll
      for (int i = i0; i < i0 + 8; ++i) {
        const int cr = CROW(i, h); const int row = rb + cr;
        float v = (ni ? c1[i] : c0[i]) * rsp[cr];
        if (rope) {
          const float pv = __shfl_xor(v, 16);
          const float cc = ccv[i - i0], sn = snv[i - i0];
          v = (r < 16) ? (v * cc - pv * sn) : (pv * sn + v * cc);
        }
        const int b = row >> 11, s = row & 2047;
        Qb[((size_t)(b * 8 + hd) * S + s) * 96 + dd] = f2bf(v * qscale);
      }
      }
    }
  };
  auto epi_kv = [=](int rb, int cb, const f32x16& c0, const f32x16& c1, const float* rsp) __attribute__((always_inline)) {
    const int lane = TIDX() & 63, r = lane & 31, h = lane >> 5;
    const int hd = cb >> 7;
    const int b = rb >> 11, s0 = rb & 2047;
    if ((cb & 127) < 64) {
#pragma unroll
      for (int i = 0; i < 16; ++i) {
        const int cr = CROW(i, h); const float sc = rsp[cr];
        const size_t o = ((size_t)(b * 8 + hd) * S + s0 + cr) * 96 + (cb & 127) + r;
        Kb[o] = f2bf(c0[i] * sc); Kb[o + 32] = f2bf(c1[i] * sc);
      }
    } else {
#pragma unroll
      for (int ni = 0; ni < 2; ++ni) {
        const int dd = (cb & 127) - 64 + 32 * ni + r;
#pragma unroll
        for (int g4 = 0; g4 < 4; ++g4) {
          const int cr = 8 * g4 + 4 * h;
          float v[4];
#pragma unroll
          for (int q = 0; q < 4; ++q) v[q] = (ni ? c1[4 * g4 + q] : c0[4 * g4 + q]) * rsp[cr + q];
          uint2 o; o.x = pack2(v[0], v[1]); o.y = pack2(v[2], v[3]);
          *(uint2*)(Vt + ((size_t)(b * 8 + hd) * 64 + dd) * S + s0 + cr) = o;
        }
      }
    }
  };
  const int nq = 128 * 6, nkv = 128 * 8, nl = 2048;
  for (int it = blockIdx.x; it < nq + nkv + nl + CONV_MLP_ITEMS; it += gridDim.x) {
    if (it >= nq + nkv + nl) { conv_mlp_item(p, smem, l, it - nq - nkv - nl); continue; }
    if (it < nq) { const int nt = it >> 7, mt = it & 127; gemm_tile<true>(smem, cqb, 256, cqb, 256, 1 << 30, WuqT, 256, mt * 128, nt * 128, 1.f / 256.f, epi_q); }
    else if (it < nq + nkv) { const int i2 = it - nq; const int nt = i2 >> 7, mt = i2 & 127; gemm_tile<true>(smem, ckvb, 128, ckvb, 128, 1 << 30, WukvT, 128, mt * 128, nt * 128, 1.f / 128.f, epi_kv); }
    else lru1_item(p, smem, l >> 1, it - nq - nkv);
  }
}

DI void phase_E3(const Params& p, char* smem) {
  char* R = p.ws + OFF_R;
  const bf16_t* Qb = (const bf16_t*)(p.ws + OFF_X);
  const bf16_t* Kb = (const bf16_t*)(R + 44 * MiB); const bf16_t* Vt = (const bf16_t*)(R + 68 * MiB);
  bf16_t* ymla = (bf16_t*)R;
  const int w = TIDX() >> 6;
  for (int it0 = blockIdx.x; it0 < 1024 + 256; it0 += gridDim.x) {
    const int pos = it0 - 256;
    const int it = (it0 < 256) ? (1024 + it0) : ((pos < 512) ? pos : (1535 - pos));
    if (it < 1024) {
      const int qb = 15 - (it >> 6), bh = it & 63, b = bh >> 3, hd = bh & 7;
      const bf16_t* Kg = Kb + (size_t)bh * S * 96;
      const bf16_t* Vg = Vt + (size_t)bh * 64 * S;
      const bf16_t* Qw = Qb + ((size_t)bh * S + qb * 128 + w * 32) * 96;
      bf16_t* op = ymla + (size_t)(b * S + qb * 128 + w * 32) * 512 + hd * 64;
      attn_core<96, 1, false>(smem, Kg, Vg, Qw, 2 * qb + 2, 2 * qb + 1 + (w >> 1), op, 512);
    } else lru2_item(p, smem, it - 1024);
  }
}

DI void phase_O1(const Params& p, char* smem, int l) {
  char* R = p.ws + OFF_R;
  bf16_t* Qd = (bf16_t*)R; bf16_t* Kd = (bf16_t*)(R + 32 * MiB); bf16_t* Vdt = (bf16_t*)(R + 40 * MiB);
  bf16_t* qi = (bf16_t*)(R + 48 * MiB); bf16_t* kib = (bf16_t*)(R + 64 * MiB);
  float* wif = (float*)(p.ws + OFF_MISC + 3 * MiB);
  const float* gk = p.in[18] + (l >> 1) * 64;
  const bf16_t* xb = (const bf16_t*)(p.ws + OFF_XB);
  const bf16_t* Wt = (const bf16_t*)(p.ws + OFF_WMIX);
  const float dscale = 0.125f * LOG2E;
  const float wscale = 0.35355339059327373f * 0.125f;
  auto epi = [=](int rb, int cb, const f32x16& c0, const f32x16& c1, const float* rsp) __attribute__((always_inline)) {
    const int lane = TIDX() & 63, r = lane & 31, h = lane >> 5;
    const int b = rb >> 11, s0 = rb & 2047;
    if (cb < 1024) {
      const int hd = cb >> 6;
#pragma unroll
      for (int i = 0; i < 16; ++i) { const int cr = CROW(i, h); const float sc = rsp[cr] * dscale; const size_t o = ((size_t)(b * 16 + hd) * S + s0 + cr) * 64 + r; Qd[o] = f2bf(c0[i] * sc); Qd[o + 32] = f2bf(c1[i] * sc); }
    } else if (cb < 1280) {
      const int g = (cb - 1024) >> 6;
#pragma unroll
      for (int i = 0; i < 16; ++i) { const int cr = CROW(i, h); const float sc = rsp[cr]; const size_t o = ((size_t)(b * 4 + g) * S + s0 + cr) * 64 + r; Kd[o] = f2bf(c0[i] * sc); Kd[o + 32] = f2bf(c1[i] * sc); }
    } else if (cb < 1536) {
      const int g = (cb - 1280) >> 6;
#pragma unroll
      for (int ni = 0; ni < 2; ++ni) {
        const int dd = 32 * ni + r;
#pragma unroll
        for (int g4 = 0; g4 < 4; ++g4) {
          const int cr = 8 * g4 + 4 * h;
          float v[4];
#pragma unroll
          for (int q = 0; q < 4; ++q) v[q] = (ni ? c1[4 * g4 + q] : c0[4 * g4 + q]) * rsp[cr + q];
          uint2 o; o.x = pack2(v[0], v[1]); o.y = pack2(v[2], v[3]);
          *(uint2*)(Vdt + ((size_t)(b * 4 + g) * 64 + dd) * S + s0 + cr) = o;
        }
      }
    } else if (cb < 2048) {
      const int hi = (cb - 1536) >> 6;
#pragma unroll
      for (int i = 0; i < 16; ++i) { const int cr = CROW(i, h); const float sc = rsp[cr]; const size_t o = ((size_t)(b * 8 + hi) * S + s0 + cr) * 64 + r; qi[o] = f2bf(c0[i] * sc); qi[o + 32] = f2bf(c1[i] * sc); }
    } else if (cb == 2048) {
      const float g0 = gk[r], g1 = gk[32 + r];
#pragma unroll
      for (int i = 0; i < 16; ++i) {
        const int cr = CROW(i, h); const float sc = rsp[cr];
        const float v0 = c0[i] * sc, v1 = c1[i] * sc;
        float ss = v0 * v0 + v1 * v1;
        ss += __shfl_xor(ss, 1); ss += __shfl_xor(ss, 2); ss += __shfl_xor(ss, 4); ss += __shfl_xor(ss, 8); ss += __shfl_xor(ss, 16);
        const float rk = rsqrtf(ss * (1.f / 64.f) + EPSV);
        const size_t o = (size_t)(rb + cr) * 64 + r;
        kib[o] = f2bf(v0 * rk * g0); kib[o + 32] = f2bf(v1 * rk * g1);
      }
    } else if (cb == 2112) {
      if (r < 8) {
#pragma unroll
        for (int i = 0; i < 16; ++i) { const int cr = CROW(i, h); wif[(size_t)(rb + cr) * 8 + r] = c0[i] * rsp[cr] * wscale; }
      }
    }
  };
  const int ng = 1024 + 128;
  for (int it = blockIdx.x; it < ng + CONV_MLP_ITEMS; it += gridDim.x) {
    if (it < 1024) { const int i9 = it & 511; const int nt = ((it >> 9) << 3) | ((i9 >> 3) & 7), mt = ((i9 >> 6) << 3) | (i9 & 7); gemm_tile_big<true>(smem, xb, 1024, Wt, 1024, mt * 256, nt * 128, 1.f / 1024.f, epi); }
    else if (it < ng) { const int mt = it - 1024; gemm_tile<true>(smem, xb, 1024, xb, 1024, 1 << 30, Wt, 1024, mt * 128, 16 * 128, 1.f / 1024.f, epi); }
    else conv_mlp_item(p, smem, l, it - ng);
  }
}

DI void phase_O3(const Params& p, char* smem) {
  char* R = p.ws + OFF_R;
  const bf16_t* Qd = (const bf16_t*)R; const bf16_t* Kd = (const bf16_t*)(R + 32 * MiB); const bf16_t* Vdt = (const bf16_t*)(R + 40 * MiB);
  const unsigned* sel = (const unsigned*)(R + 66 * MiB);
  bf16_t* yd = (bf16_t*)(R + 70 * MiB);
  unsigned* maskl = (unsigned*)(smem + 22016);
  const int tid = TIDX(), w = tid >> 6;
  for (int it0 = blockIdx.x; it0 < 1024; it0 += gridDim.x) {
    const int it = (it0 < 512) ? it0 : (1535 - it0);
    const int c = 31 - (it >> 5), bg = it & 31, b = bg >> 2, g = bg & 3;
    const bool use_mask = c >= 4;
    __syncthreads();
    {
      const int nw = 2 * (c + 1);
      unsigned mv[16];
#pragma unroll
      for (int i = 0; i < 16; ++i) { const int e = tid + 256 * i, q = e >> 6, wd = e & 63; mv[i] = (use_mask && wd < nw) ? sel[(size_t)(b * S + c * 64 + q) * 64 + wd] : 0xffffffffu; }
#pragma unroll
      for (int i = 0; i < 16; ++i) { const int e = tid + 256 * i, q = e >> 6, wd = e & 63; if (wd < nw) maskl[q * 65 + wd] = mv[i]; }
    }
    const int head = 4 * g + w;
    const bf16_t* Kg = Kd + (size_t)bg * S * 64;
    const bf16_t* Vg = Vdt + (size_t)bg * 64 * S;
    const bf16_t* Qw = Qd + ((size_t)(b * 16 + head) * S + c * 64) * 64;
    bf16_t* op = yd + (size_t)(b * S + c * 64) * 1024 + head * 64;
    attn_core<64, 2, true>(smem, Kg, Vg, Qw, c + 1, c + 1, op, 1024);
  }
}

DI void phase_M1(const Params& p, char* smem, int l) {
  const bf16_t* xb = (const bf16_t*)(p.ws + OFF_XB);
  const bf16_t* W1t = (const bf16_t*)(p.ws + OFF_WMLP);
  bf16_t* a = (bf16_t*)(p.ws + OFF_R);
  auto epi = [=](int rb, int cb, const f32x16& c0, const f32x16& c1, const float* rsp) __attribute__((always_inline)) {
    const int lane = TIDX() & 63, r = lane & 31, h = lane >> 5;
#pragma unroll
    for (int i = 0; i < 16; ++i) {
      const int cr = CROW(i, h); const float sc = rsp[cr];
      const size_t o = (size_t)(rb + cr) * 4096 + cb + r;
      const float v0 = fmaxf(c0[i] * sc, 0.f), v1 = fmaxf(c1[i] * sc, 0.f);
      a[o] = f2bf(v0 * v0); a[o + 32] = f2bf(v1 * v1);
    }
  };
  const int ng = 64 * 32;
  const int ncv = (l < 3) ? conv_mix_count(l + 1) : 0;
  for (int it = blockIdx.x; it < ng + ncv; it += gridDim.x) {
    if (it < ng) { const int i9 = it & 511; const int nt = ((it >> 9) << 3) | ((i9 >> 3) & 7), mt = ((i9 >> 6) << 3) | (i9 & 7); gemm_tile_big<true>(smem, xb, 1024, W1t, 1024, mt * 256, nt * 128, 1.f / 1024.f, epi); }
    else conv_mix_item(p, smem, l + 1, it - ng);
  }
}

DI void run_phase(const Params& p, int ph, char* smem) {
#ifndef PHM
#define PHM 0xffff
#endif
  if (ph == 0) { if (PHM & 1) phase_prologue(p, smem); return; }
  if (ph == NPHASE - 1) { if (PHM & 2) phase_final(p); return; }
  const int l = (ph - 1) / 6, sub = (ph - 1) - l * 6;
  const bool odd = l & 1;
  char* R = p.ws + OFF_R;
  const float* xcur = (l == 0) ? p.in[0] : nullptr;
  switch (sub) {
    case 0: if (odd) { if (PHM & 4) phase_O1(p, smem, l); } else { if (PHM & 8) phase_E1(p, smem, l); } break;
    case 1:
      if (odd) { if (PHM & 16) for (int it0 = blockIdx.x; it0 < 896; it0 += gridDim.x) topk_item(p, smem, (it0 < 512) ? it0 : (1407 - it0)); }
      else { if (PHM & 32) phase_E2(p, smem, l); }
      break;
    case 2: if (odd) { if (PHM & 64) phase_O3(p, smem); } else { if (PHM & 128) phase_E3(p, smem); } break;
    case 3:
      if (!(PHM & 512)) break;
      if (odd) phase_resid_gemm(p, smem, (const bf16_t*)(R + 70 * MiB), 1024, (const bf16_t*)(R + 70 * MiB), 1024, 1 << 30,
                                (const bf16_t*)(p.ws + OFF_WMIX + 4 * MiB + 512 * 1024), 1024, xcur, false);
      else phase_resid_gemm(p, smem, (const bf16_t*)(R + 100 * MiB), 512, (const bf16_t*)R, 512, 512,
                            (const bf16_t*)(p.ws + OFF_WMIX + 4 * MiB), 1024, xcur, false);
      break;
    case 4: if (PHM & 256) phase_M1(p, smem, l); break;
    case 5: phase_resid_gemm(p, smem, (const bf16_t*)R, 4096, (const bf16_t*)R, 4096, 1 << 30, (const bf16_t*)(p.ws + OFF_WMLP + 8 * MiB), 4096,
                             nullptr, l == 3); break;
  }
}


#define XB_TMO      128
#define XB_XCNT(j)  (256  + 64 * (j))
#define XB_XSUB(j)  (1280 + 64 * (j))
#define XB_XGEN(j)  (2304 + 64 * (j))
#define XB_TOP      3328
#define XB_TOPGEN   3392
#define XCD_BAR_WORDS 3456
#define XB_SPIN_CAP (1u << 22)
#define LAS __attribute__((address_space(3)))
DI unsigned xb_ld(unsigned* p)              { return __hip_atomic_load(p, __ATOMIC_RELAXED, __HIP_MEMORY_SCOPE_AGENT); }
DI unsigned xb_add(unsigned* p, unsigned v) { return __hip_atomic_fetch_add(p, v, __ATOMIC_RELAXED, __HIP_MEMORY_SCOPE_AGENT); }
DI unsigned xb_xcc_id() { return (unsigned)__builtin_amdgcn_s_getreg((3 << 11) | 20) & 0xFu; }
#define XB_SPIN(cond, bar) do { unsigned _sp = 0; while (cond) { __builtin_amdgcn_s_sleep(1); \
    if ((++_sp & 255u) == 0u) { if (xb_ld(&(bar)[XB_TMO])) break; if (_sp > XB_SPIN_CAP) { atomicAdd(&(bar)[XB_TMO], 1u); break; } } } } while (0)
struct XcdBarrier { unsigned* bar; unsigned x; volatile LAS unsigned* st; };
DI XcdBarrier xcd_barrier_post(unsigned* bar, volatile LAS unsigned* st) {
  XcdBarrier b; b.bar = bar; b.x = xb_xcc_id(); b.st = st;
  if (__builtin_amdgcn_workitem_id_x() == 0) (void)xb_add(&bar[XB_XCNT(b.x)], 1u);
  return b;
}
DI void xcd_barrier_complete(unsigned* bar, unsigned x, unsigned& nloc, unsigned& nx) {
  const unsigned G = gridDim.x * gridDim.y * gridDim.z;
  unsigned sum, cnt, mine, sp = 0u;
  for (;;) {
    sum = 0u; cnt = 0u; mine = 0u;
#pragma unroll
    for (unsigned j = 0; j < 16; ++j) { const unsigned c = xb_ld(&bar[XB_XCNT(j)]); sum += c; cnt += (c > 0u) ? 1u : 0u; mine = (j == x) ? c : mine; }
    if (sum == G) break;
    __builtin_amdgcn_s_sleep(1);
    if ((++sp & 255u) == 0u) { if (xb_ld(&bar[XB_TMO])) break; if (sp > XB_SPIN_CAP) { atomicAdd(&bar[XB_TMO], 1u); break; } }
  }
  nloc = mine > 0u ? mine : 1u; nx = cnt > 0u ? cnt : 1u;
}
DI void xcd_barrier(const XcdBarrier& b) {
  asm volatile("s_waitcnt vmcnt(0)" ::: "memory");
  __syncthreads();
  if (__builtin_amdgcn_workitem_id_x() == 0) {
    unsigned* bar = b.bar;
    __builtin_amdgcn_s_waitcnt(0);
    unsigned nloc = b.st[0], nx = b.st[1];
    if (nloc == 0u) { xcd_barrier_complete(bar, b.x, nloc, nx); b.st[0] = nloc; b.st[1] = nx; }
    const unsigned old = xb_add(&bar[XB_XSUB(b.x)], 1u);
    const unsigned gen = old / nloc;
    if (old + 1u == (gen + 1u) * nloc) {
      __builtin_amdgcn_fence(__ATOMIC_RELEASE, "agent");
      asm volatile("s_waitcnt vmcnt(0)" ::: "memory");
      const unsigned og = xb_add(&bar[XB_TOP], 1u);
      const unsigned tg = og / nx;
      if (og + 1u == (tg + 1u) * nx) xb_add(&bar[XB_TOPGEN], 1u);
      else XB_SPIN(xb_ld(&bar[XB_TOPGEN]) == tg, bar);
      __builtin_amdgcn_fence(__ATOMIC_ACQUIRE, "agent");
      xb_add(&bar[XB_XGEN(b.x)], 1u);
      asm volatile("s_waitcnt vmcnt(0)" ::: "memory");
    } else {
      XB_SPIN(xb_ld(&bar[XB_XGEN(b.x)]) == gen, bar);
      __builtin_amdgcn_fence(__ATOMIC_ACQUIRE, "agent");
      asm volatile("s_waitcnt vmcnt(0)" ::: "memory");
    }
  }
  __syncthreads();
}
constexpr size_t OFF_BAR = OFF_MISC + 4 * MiB;

__global__ void __launch_bounds__(256, 2) mega_kernel(Params p) {
  __shared__ __attribute__((aligned(16))) char smem[SMEM_BYTES];
  cg::grid_group grid = cg::this_grid();
  if (__builtin_amdgcn_workitem_id_x() == 0) *(uint4*)(smem + SMEM_BYTES - 16) = make_uint4(0u, 0u, 0u, 0u);
  __syncthreads();
  XcdBarrier xb = xcd_barrier_post((unsigned*)(p.ws + OFF_BAR), (volatile LAS unsigned*)(smem + SMEM_BYTES - 16));
  for (int ph = p.phase_lo; ph < p.phase_hi; ++ph) {
    if (ph > p.phase_lo) {
      if (p.pad0 != 0) grid.sync();
      xcd_barrier(xb);
    }
    run_phase(p, ph, smem);
#ifdef PROBE_SUB
    if (ph > 0 && ph < NPHASE - 1 && ((ph - 1) % 6) == PROBE_SUB && ((((ph - 1) / 6) & 1) == PROBE_ODD)) { xcd_barrier(xb); run_phase(p, ph, smem); }
#endif
  }
}

extern "C" void kernel_launch(void* const* d_in, const int* in_sizes, int n_in, void* d_out, int out_size, void* d_ws, size_t ws_size,
                              hipStream_t stream) {
  Params p;
  memset(&p, 0, sizeof(p));
  for (int i = 0; i < 24; ++i) p.in[i] = (const float*)d_in[i];
  p.pos = (const int*)d_in[1];
  p.out = (float*)d_out;
  p.ws = (char*)d_ws;
  static int grid_blocks = 0;
  if (!grid_blocks) {
    int dev = 0, cus = 0, per_cu = 0;
    hipGetDevice(&dev);
    hipDeviceGetAttribute(&cus, hipDeviceAttributeMultiprocessorCount, dev);
    hipOccupancyMaxActiveBlocksPerMultiprocessor(&per_cu, mega_kernel, 256, 0);
    if (per_cu > 2) per_cu = 2;
    if (per_cu < 1) per_cu = 1;
    grid_blocks = cus * per_cu;
  }
  (void)hipMemsetAsync((char*)d_ws + OFF_BAR, 0, XCD_BAR_WORDS * sizeof(unsigned), stream);
#if MULTI_LAUNCH
  for (int ph = 0; ph < NPHASE; ++ph) {
    p.phase_lo = ph; p.phase_hi = ph + 1;
    hipLaunchKernelGGL(mega_kernel, dim3(grid_blocks), dim3(256), 0, stream, p);
  }
#else
  p.phase_lo = 0; p.phase_hi = NPHASE;
  void* args[] = {&p};
  hipError_t e = hipLaunchCooperativeKernel((void*)mega_kernel, dim3(grid_blocks), dim3(256), args, 0, stream);
  if (e != hipSuccess) fprintf(stderr, "cooperative launch failed: %s (grid %d)\n", hipGetErrorString(e), grid_blocks);
#endif
}
```
